# Optimizing an MI355X kernel written in HIP

```python
import jax, jax.numpy as jnp
from jax import lax
import numpy as np

D_MODEL = 1024
BATCH = 8
SEQ = 8192
DEPTH = 2

GRID_W = 64
CTX_LEN = 256
N_EVEN = (DEPTH + 1) // 2
N_ODD = DEPTH // 2
EPS = 1e-6

POOL_WINDOWS = (2, 4, 8, 16)
POOL_GROUPS = len(POOL_WINDOWS)
POOL_GROUP_DIM = D_MODEL // 16
POOL_DIM = POOL_GROUPS * POOL_GROUP_DIM

HEAD_DIM = 128
N_Q_HEADS = 6
N_KV_HEADS = 2
Q_PER_KV = N_Q_HEADS // N_KV_HEADS
ATTN_DIM = N_Q_HEADS * HEAD_DIM
KV_DIM = N_KV_HEADS * HEAD_DIM
ROPE_THETA = 10000.0
Q_BLOCK = 128
MIX_WIDTH = POOL_DIM + ATTN_DIM
IN_A_WIDTH = POOL_DIM + ATTN_DIM + 2 * KV_DIM

D_INNER = 2 * D_MODEL
SSM_HEAD_DIM = 64
SSM_HEADS = D_INNER // SSM_HEAD_DIM
SSM_GROUPS = 4
HEADS_PER_GROUP = SSM_HEADS // SSM_GROUPS
D_STATE = 128
D_CONV = 4
SSD_CHUNK = 128
CONV_DIM = D_INNER + 2 * SSM_GROUPS * D_STATE
IN_C_WIDTH = D_INNER + CONV_DIM + 2 * SSM_HEADS

D_FF = 2816
FFN_CONV = 3

kernel_name = "hybrid_pool_attn_ssd_convffn_dit"


def rms_norm(x, w):
    xf = x.astype(jnp.float32)
    y = xf * lax.rsqrt(jnp.mean(xf * xf, axis=-1, keepdims=True) + EPS)
    return (y * w.astype(jnp.float32)).astype(x.dtype)


def adaln(cond, w, b):
    return jax.nn.silu(cond) @ w + b


def modulate(h, shift, scale):
    return h * (1.0 + scale) + shift


def depthwise_conv_centred(u, w, b):
    T = u.shape[1]
    K = w.shape[1]
    left = K // 2
    right = K - 1 - left
    up = jnp.pad(u, ((0, 0), (left, right), (0, 0)))
    out = b
    for k in range(K):
        out = out + up[:, k:k + T] * w[:, k]
    return out


def axial_rope_tables(T):
    rows = T // GRID_W
    row = jnp.repeat(jnp.arange(rows, dtype=jnp.float32), GRID_W)
    col = jnp.tile(jnp.arange(GRID_W, dtype=jnp.float32), rows)
    half = HEAD_DIM // 2
    inv_freq = ROPE_THETA ** (-jnp.arange(0, half, 2, dtype=jnp.float32) / half)
    ang = jnp.concatenate([row[:, None] * inv_freq, col[:, None] * inv_freq], axis=-1)
    return jnp.cos(ang), jnp.sin(ang)


def apply_rope(x, cos, sin):
    cos = cos[None, :, None, :].astype(x.dtype)
    sin = sin[None, :, None, :].astype(x.dtype)
    x1 = x[..., 0::2]
    x2 = x[..., 1::2]
    r1 = x1 * cos - x2 * sin
    r2 = x1 * sin + x2 * cos
    return jnp.stack([r1, r2], axis=-1).reshape(x.shape)


def centred_window_mean(u, w):
    T = u.shape[1]
    left = w // 2
    right = w - 1 - left
    up = jnp.pad(u.astype(jnp.float32), ((0, 0), (left + 1, right), (0, 0)))
    cs = jnp.cumsum(up, axis=1)
    total = cs[:, w:] - cs[:, :T]
    t = jnp.arange(T)
    cnt = (jnp.minimum(t + right, T - 1) - jnp.maximum(t - left, 0) + 1).astype(jnp.float32)
    return (total / cnt[None, :, None]).astype(u.dtype)


def pool_mixer(u, pool_w, pool_scale):
    B, T, _ = u.shape
    parts = []
    for g, w in enumerate(POOL_WINDOWS):
        ug = u[..., g * POOL_GROUP_DIM:(g + 1) * POOL_GROUP_DIM]
        parts.append(centred_window_mean(ug, w) - ug)
    p = jnp.stack(parts, axis=2)
    y = jnp.einsum("btgi,gio->btgo", p, pool_w).reshape(B, T, POOL_DIM)
    return y * pool_scale


def attention_latent(q_l, k_all, v_all):
    B, T = q_l.shape[:2]
    nb = T // Q_BLOCK
    scale = HEAD_DIM ** -0.5
    qb = q_l.reshape(B, nb, Q_BLOCK, N_KV_HEADS, Q_PER_KV, HEAD_DIM).transpose(1, 0, 2, 3, 4, 5)

    def block(q_blk):
        s = jnp.einsum("bqhgd,bkhd->bhgqk", q_blk, k_all).astype(jnp.float32) * scale
        p = jax.nn.softmax(s, axis=-1).astype(v_all.dtype)
        return jnp.einsum("bhgqk,bkhd->bqhgd", p, v_all)

    o = lax.map(block, qb)
    return o.transpose(1, 0, 2, 3, 4, 5).reshape(B, T, ATTN_DIM)


def attention_context(q_c, k_c, v_c):
    B, L = q_c.shape[:2]
    q = q_c.reshape(B, L, N_KV_HEADS, Q_PER_KV, HEAD_DIM)
    s = jnp.einsum("bqhgd,bkhd->bhgqk", q, k_c).astype(jnp.float32) * (HEAD_DIM ** -0.5)
    p = jax.nn.softmax(s, axis=-1).astype(v_c.dtype)
    return jnp.einsum("bhgqk,bkhd->bqhgd", p, v_c).reshape(B, L, ATTN_DIM)


def pool_attention_mixer(h_l, h_c, cos, sin, w_in, pool_w, pool_scale, q_gain, k_gain, w_out, need_ctx):
    def project(h):
        B, T, _ = h.shape
        u = h @ w_in
        a = u[..., :POOL_DIM]
        q = u[..., POOL_DIM:POOL_DIM + ATTN_DIM].reshape(B, T, N_Q_HEADS, HEAD_DIM)
        k = u[..., POOL_DIM + ATTN_DIM:POOL_DIM + ATTN_DIM + KV_DIM].reshape(B, T, N_KV_HEADS, HEAD_DIM)
        v = u[..., POOL_DIM + ATTN_DIM + KV_DIM:].reshape(B, T, N_KV_HEADS, HEAD_DIM)
        return a, rms_norm(q, q_gain), rms_norm(k, k_gain), v

    a_l, q_l, k_l, v_l = project(h_l)
    q_l = apply_rope(q_l, cos, sin)
    k_l = apply_rope(k_l, cos, sin)
    a_c, q_c, k_c, v_c = project(h_c)
    k_all = jnp.concatenate([k_c, k_l], axis=1)
    v_all = jnp.concatenate([v_c, v_l], axis=1)
    o_l = attention_latent(q_l, k_all, v_all)
    y_l = jnp.concatenate([pool_mixer(a_l, pool_w, pool_scale), o_l], axis=-1) @ w_out
    y_c = None
    if need_ctx:
        o_c = attention_context(q_c, k_c, v_c)
        y_c = jnp.concatenate([pool_mixer(a_c, pool_w, pool_scale), o_c], axis=-1) @ w_out
    return y_l, y_c


def ssd_scan(xs, dt, A, Bm, Cm, h0):
    Bsz, T = xs.shape[:2]
    nc = T // SSD_CHUNK
    Q = SSD_CHUNK
    xdt = (xs.astype(jnp.float32) * dt[..., None]).reshape(Bsz, nc, Q, SSM_GROUPS, HEADS_PER_GROUP, SSM_HEAD_DIM)
    a = (dt * A).reshape(Bsz, nc, Q, SSM_GROUPS, HEADS_PER_GROUP)
    a_cum = jnp.cumsum(a, axis=2)
    Bc = Bm.astype(jnp.float32).reshape(Bsz, nc, Q, SSM_GROUPS, D_STATE)
    Cc = Cm.astype(jnp.float32).reshape(Bsz, nc, Q, SSM_GROUPS, D_STATE)
    lower = jnp.tril(jnp.ones((Q, Q), dtype=bool))[None, :, :, None, None]

    def chunk_step(h, inp):
        xq, aq, Bq, Cq = inp
        seg = aq[:, :, None] - aq[:, None, :]
        Lmat = jnp.exp(jnp.where(lower, seg, -jnp.inf))
        cb = jnp.einsum("blgn,bsgn->blsg", Cq, Bq)
        y = (jnp.einsum("blsg,blsgh,bsghp->blghp", cb, Lmat, xq)
             + jnp.einsum("blgn,bghpn,blgh->blghp", Cq, h, jnp.exp(aq)))
        decay_to_end = jnp.exp(aq[:, -1:] - aq)
        h_new = (jnp.exp(aq[:, -1])[..., None, None] * h
                 + jnp.einsum("bsgn,bsgh,bsghp->bghpn", Bq, decay_to_end, xq))
        return h_new, y

    inputs = (jnp.swapaxes(xdt, 0, 1), jnp.swapaxes(a_cum, 0, 1), jnp.swapaxes(Bc, 0, 1), jnp.swapaxes(Cc, 0, 1))
    h_final, ys = lax.scan(chunk_step, h0, inputs)
    y = jnp.swapaxes(ys, 0, 1).reshape(Bsz, T, SSM_HEADS, SSM_HEAD_DIM)
    return y.astype(xs.dtype), h_final


def bidirectional_ssd_mixer(h_l, h_c, w_in, conv_w, conv_b, A_log, dt_bias, D_skip, norm_w, w_out, need_ctx):
    A = -jnp.exp(A_log.astype(jnp.float32))

    def prep(h):
        B, T, _ = h.shape
        u = h @ w_in
        z = u[..., :D_INNER]
        xbc = jax.nn.silu(depthwise_conv_centred(u[..., D_INNER:D_INNER + CONV_DIM], conv_w, conv_b))
        dt_raw = u[..., D_INNER + CONV_DIM:].reshape(B, T, 2, SSM_HEADS)
        xs = xbc[..., :D_INNER].reshape(B, T, SSM_HEADS, SSM_HEAD_DIM)
        Bm = xbc[..., D_INNER:D_INNER + SSM_GROUPS * D_STATE].reshape(B, T, SSM_GROUPS, D_STATE)
        Cm = xbc[..., D_INNER + SSM_GROUPS * D_STATE:].reshape(B, T, SSM_GROUPS, D_STATE)
        dt = jax.nn.softplus(dt_raw.astype(jnp.float32) + dt_bias.astype(jnp.float32))
        return z, xs, Bm, Cm, dt

    def run(z, xs, Bm, Cm, dt, h0_f, h0_b):
        fl = lambda t: jnp.flip(t, axis=1)
        y_f, hf = ssd_scan(xs, dt[:, :, 0], A[0], Bm, Cm, h0_f)
        y_b, hb = ssd_scan(fl(xs), fl(dt[:, :, 1]), A[1], fl(Bm), fl(Cm), h0_b)
        y = y_f + fl(y_b) + D_skip[:, None] * xs
        B, T = xs.shape[:2]
        y = rms_norm(y.reshape(B, T, D_INNER) * jax.nn.silu(z), norm_w)
        return y @ w_out, hf, hb

    zc, xc, Bc, Cc, dtc = prep(h_c)
    zeros = jnp.zeros((h_c.shape[0], SSM_GROUPS, HEADS_PER_GROUP, SSM_HEAD_DIM, D_STATE), jnp.float32)
    y_c = None
    if need_ctx:
        y_c, hc_f, hc_b = run(zc, xc, Bc, Cc, dtc, zeros, zeros)
    else:
        fl = lambda t: jnp.flip(t, axis=1)
        _, hc_f = ssd_scan(xc, dtc[:, :, 0], A[0], Bc, Cc, zeros)
        _, hc_b = ssd_scan(fl(xc), fl(dtc[:, :, 1]), A[1], fl(Bc), fl(Cc), zeros)
    zl, xl, Bl, Cl, dtl = prep(h_l)
    y_l, _, _ = run(zl, xl, Bl, Cl, dtl, hc_f, hc_b)
    return y_l, y_c


def conv_ffn(h, w_up, conv_w, conv_b, w_down):
    u = depthwise_conv_centred(h @ w_up, conv_w, conv_b)
    val = u[..., :D_FF]
    gate = u[..., D_FF:]
    return (jax.nn.silu(gate) * val) @ w_down


def setup_inputs(seed: int = 0) -> dict:
    key = jax.random.key(seed)
    ks = jax.random.split(key, 28)
    f32 = jnp.float32
    nrm = lambda k, s: jax.random.normal(k, s, f32)
    dense = lambda k, s, fan_in: nrm(k, s) * fan_in ** -0.5
    gain = lambda k, s: 1.0 + 0.05 * nrm(k, s)
    dt0 = jnp.exp(jax.random.uniform(ks[17], (N_ODD, 2, SSM_HEADS), f32, np.log(1e-3), np.log(1e-1)))
    return {
        "x": nrm(ks[0], (BATCH, SEQ, D_MODEL)),
        "c": nrm(ks[1], (BATCH, D_MODEL)),
        "ctx": nrm(ks[2], (BATCH, CTX_LEN, D_MODEL)),
        "c_ctx": nrm(ks[3], (D_MODEL,)),
        "ada_w": 0.5 * dense(ks[4], (DEPTH, D_MODEL, 6 * D_MODEL), D_MODEL),
        "ada_b": 0.02 * nrm(ks[5], (DEPTH, 6 * D_MODEL)),
        "norm_w": gain(ks[6], (DEPTH, 4, D_MODEL)),
        "attn_w_in": dense(ks[7], (N_EVEN, D_MODEL, IN_A_WIDTH), D_MODEL),
        "pool_w": dense(ks[8], (N_EVEN, POOL_GROUPS, POOL_GROUP_DIM, POOL_GROUP_DIM), POOL_GROUP_DIM),
        "pool_scale": gain(ks[9], (N_EVEN, POOL_DIM)),
        "q_gain": gain(ks[10], (N_EVEN, HEAD_DIM)),
        "k_gain": gain(ks[11], (N_EVEN, HEAD_DIM)),
        "attn_w_out": dense(ks[12], (N_EVEN, MIX_WIDTH, D_MODEL), MIX_WIDTH),
        "ssm_w_in": dense(ks[13], (N_ODD, D_MODEL, IN_C_WIDTH), D_MODEL),
        "ssm_conv_w": dense(ks[14], (N_ODD, CONV_DIM, D_CONV), D_CONV),
        "ssm_conv_b": 0.02 * nrm(ks[15], (N_ODD, CONV_DIM)),
        "ssm_A_log": jnp.log(jax.random.uniform(ks[16], (N_ODD, 2, SSM_HEADS), f32, 1.0, 16.0)),
        "ssm_dt_bias": dt0 + jnp.log(-jnp.expm1(-dt0)),
        "ssm_D": gain(ks[18], (N_ODD, SSM_HEADS)),
        "ssm_norm_w": gain(ks[19], (N_ODD, D_INNER)),
        "ssm_w_out": dense(ks[20], (N_ODD, D_INNER, D_MODEL), D_INNER),
        "ffn_w_up": dense(ks[21], (DEPTH, D_MODEL, 2 * D_FF), D_MODEL),
        "ffn_conv_w": dense(ks[22], (DEPTH, 2 * D_FF, FFN_CONV), FFN_CONV),
        "ffn_conv_b": 0.02 * nrm(ks[23], (DEPTH, 2 * D_FF)),
        "ffn_w_down": dense(ks[24], (DEPTH, D_FF, D_MODEL), D_FF),
    }


def reference(x, c, ctx, c_ctx, ada_w, ada_b, norm_w, attn_w_in, pool_w, pool_scale, q_gain, k_gain,
              attn_w_out, ssm_w_in, ssm_conv_w, ssm_conv_b, ssm_A_log, ssm_dt_bias, ssm_D, ssm_norm_w,
              ssm_w_out, ffn_w_up, ffn_conv_w, ffn_conv_b, ffn_w_down):
    T = x.shape[1]
    cos, sin = axial_rope_tables(T)
    for i in range(DEPTH):
        last = i == DEPTH - 1
        j = i // 2
        mod_l = jnp.split(adaln(c, ada_w[i], ada_b[i])[:, None, :], 6, axis=-1)
        mod_c = jnp.split(adaln(c_ctx, ada_w[i], ada_b[i])[None, None, :], 6, axis=-1)
        h_l = modulate(rms_norm(x, norm_w[i, 0]), mod_l[0], mod_l[1])
        h_c = modulate(rms_norm(ctx, norm_w[i, 0]), mod_c[0], mod_c[1])
        if i % 2 == 0:
            y_l, y_c = pool_attention_mixer(h_l, h_c, cos, sin, attn_w_in[j], pool_w[j], pool_scale[j],
                                            q_gain[j], k_gain[j], attn_w_out[j], not last)
        else:
            y_l, y_c = bidirectional_ssd_mixer(h_l, h_c, ssm_w_in[j], ssm_conv_w[j], ssm_conv_b[j], ssm_A_log[j],
                                               ssm_dt_bias[j], ssm_D[j], ssm_norm_w[j], ssm_w_out[j], not last)
        x = x + mod_l[2] * rms_norm(y_l, norm_w[i, 1])
        f_l = conv_ffn(modulate(rms_norm(x, norm_w[i, 2]), mod_l[3], mod_l[4]),
                       ffn_w_up[i], ffn_conv_w[i], ffn_conv_b[i], ffn_w_down[i])
        x = x + mod_l[5] * rms_norm(f_l, norm_w[i, 3])
        if not last:
            ctx = ctx + mod_c[2] * rms_norm(y_c, norm_w[i, 1])
            f_c = conv_ffn(modulate(rms_norm(ctx, norm_w[i, 2]), mod_c[3], mod_c[4]),
                           ffn_w_up[i], ffn_conv_w[i], ffn_conv_b[i], ffn_w_down[i])
            ctx = ctx + mod_c[5] * rms_norm(f_c, norm_w[i, 3])
    return x
```

```cpp
#include <hip/hip_runtime.h>
#include <hip/hip_bf16.h>
#include <hip/hip_cooperative_groups.h>
#include <cstdio>
#include <cstdint>
namespace cg = cooperative_groups;

#define LAS __attribute__((address_space(3)))
typedef unsigned short bf16_t;
typedef short bf16x8 __attribute__((ext_vector_type(8)));
typedef short s16x4 __attribute__((ext_vector_type(4)));
typedef short v4i16_t __attribute__((ext_vector_type(4)));
typedef float f32x4 __attribute__((ext_vector_type(4)));
typedef float f32x16 __attribute__((ext_vector_type(16)));
typedef unsigned u32x4 __attribute__((ext_vector_type(4)));
typedef unsigned u32x2 __attribute__((ext_vector_type(2)));

constexpr int DM = 1024, NB = 8, SEQ = 8192, CTXL = 256, RPB = SEQ + CTXL, MR = NB * RPB, MT = NB * SEQ;
constexpr int INA = 1536, DFF = 2816, DFF2 = 5632, DIN = 2048, CONVD = 3072, NXD = 3328, SINP = 5376, INC = 5184;
constexpr float EPS = 1e-6f;
constexpr int LDS_BYTES = 152576;

constexpr size_t MiB = 1u << 20;
constexpr size_t WS_MOD = 0;
constexpr size_t WS_ROWSS = 512 * 1024;
constexpr size_t WS_BAR = 1024 * 1024 - 4096;
constexpr size_t WS_WB = 1 * MiB;
constexpr size_t W_AIN = WS_WB, W_AOUT = WS_WB + 3 * MiB, W_UP0 = WS_WB + 5 * MiB, W_DN0 = WS_WB + 16 * MiB;
constexpr size_t W_SIN = WS_WB + 22 * MiB, W_SOUT = WS_WB + 33 * MiB, W_UP1 = WS_WB + 37 * MiB, W_DN1 = WS_WB + 48 * MiB;
constexpr size_t WS_CX = 56 * MiB;
constexpr size_t WS_YX = 64 * MiB;
constexpr size_t WS_HALO = 196 * MiB;
constexpr size_t WS_BIG = 220 * MiB;
constexpr size_t WS_XRES = WS_BIG + 672 * MiB;
constexpr size_t WS_END = WS_XRES + 132 * MiB;
constexpr size_t BIG_U = WS_BIG, BIG_MIX = WS_BIG + 198 * MiB, BIG_UP = WS_BIG, BIG_H = WS_BIG;
constexpr size_t BIG_XBC = WS_BIG, BIG_DT = WS_BIG + 396 * MiB, BIG_YS = WS_BIG + 416 * MiB, BIG_YOUT = WS_BIG;

struct Params { const float* in[25]; float* out; unsigned char* ws; };
typedef const Params __attribute__((address_space(4)))* KP;
enum { I_X = 0, I_C, I_CTX, I_CCTX, I_ADAW, I_ADAB, I_NORMW, I_AWIN, I_POOLW, I_POOLS, I_QG, I_KG, I_AWOUT, I_SWIN, I_SCW, I_SCB, I_SALOG, I_SDTB, I_SD, I_SNW, I_SWOUT, I_FUP, I_FCW, I_FCB, I_FDN };

typedef float f32x2_t __attribute__((ext_vector_type(2))); typedef __bf16 bf16x2_t __attribute__((ext_vector_type(2)));
__device__ __forceinline__ unsigned cvt_pk_bf16(float lo, float hi) { f32x2_t v = {lo, hi}; bf16x2_t b = __builtin_convertvector(v, bf16x2_t); return __builtin_bit_cast(unsigned, b); }
__device__ __forceinline__ float bflo(unsigned w) { return __uint_as_float(w << 16); }
__device__ __forceinline__ float bfhi(unsigned w) { return __uint_as_float(w & 0xffff0000u); }
__device__ __forceinline__ void unpack8(const u32x4 q, float (&f)[8]) {
    f[0] = bflo(q.x); f[1] = bfhi(q.x); f[2] = bflo(q.y); f[3] = bfhi(q.y); f[4] = bflo(q.z); f[5] = bfhi(q.z); f[6] = bflo(q.w); f[7] = bfhi(q.w);
}
__device__ __forceinline__ u32x4 pack8(const float (&f)[8]) {
    u32x4 q; q.x = cvt_pk_bf16(f[0], f[1]); q.y = cvt_pk_bf16(f[2], f[3]); q.z = cvt_pk_bf16(f[4], f[5]); q.w = cvt_pk_bf16(f[6], f[7]); return q;
}
__device__ __forceinline__ float shx(float v, int mask, int lane) { return __int_as_float(__builtin_amdgcn_ds_bpermute(((lane ^ mask) & 63) << 2, __float_as_int(v))); }
__device__ __forceinline__ float shup(float v, int o, int lane) { return __int_as_float(__builtin_amdgcn_ds_bpermute(((lane - o) & 63) << 2, __float_as_int(v))); }
__device__ __forceinline__ float rdlane(float v, int i) { return __int_as_float(__builtin_amdgcn_readlane(__float_as_int(v), i)); }
__device__ __forceinline__ float wave_sum(float v, int lane) {
#pragma unroll
    for (int o = 1; o < 64; o <<= 1) v += shx(v, o, lane);
    return v;
}
__device__ __forceinline__ float siluf(float v) { return v * __builtin_amdgcn_rcpf(1.f + __expf(-v)); }

namespace pg8 {
constexpr int BM = 256, BK = 64, HALF = 128, HTB = HALF * BK * 2, STAGE_BYTES = 8 * HTB, NXCD = 8, WGM = 8;
__host__ __device__ __forceinline__ int lds_byte(int r, int c) { const int st = (r >> 4) * 2 + (c >> 5), rr = r & 15, cc = c & 31, ob = rr * 64 + cc * 2; return st * 1024 + (ob ^ (((ob >> 9) & 1) << 5)); }
__host__ __device__ __forceinline__ void stage_rc(int b, int& R, int& C) { const int st = b / 1024, sb = b % 1024, swz = sb ^ (((sb >> 9) & 1) << 5); R = (st >> 1) * 16 + swz / 64; C = (st & 1) * 32 + (swz % 64) / 2; }
__host__ __device__ __forceinline__ int perm32(int rho) { const int n = rho >> 4, i = rho & 15; return 8 * (i >> 2) + 4 * n + (i & 3); }

struct Unit { int pm, pn; };
struct Gemm { const bf16_t* A; const bf16_t* Bt; int M, N, K, lda, amap, cmode; };
__device__ __forceinline__ int tile_a(const Gemm& g, int pm) { return g.amap ? pm + (pm >> 5) + 1 : pm; }

struct StaticOrder {
    int nM, nN, nwg, G, c;
    __device__ void init(int nM_, int N, int G_, int c_) { nM = nM_; nN = N / BM; nwg = nM * nN; G = G_; c = c_; }
    __device__ bool next(int i, Unit& u) const {
        const long L = (long)i * G + c; if (L >= nwg) return false;
        int wgid = (int)L; { const int q = nwg / NXCD, r = nwg % NXCD, xcd = wgid % NXCD, off = wgid / NXCD; wgid = (xcd < r ? xcd * (q + 1) : r * (q + 1) + (xcd - r) * q) + off; }
        const int nig = WGM * nN, gid = wgid / nig, fm = gid * WGM, gsz = (nM - fm) < WGM ? (nM - fm) : WGM;
        u.pm = fm + ((wgid % nig) % gsz); u.pn = (wgid % nig) / gsz; return true;
    }
};

struct EpiMulti {
    static constexpr bool PERM = true;
    int mode;
    bf16_t* O; int ldc; float* dt; const float* dtb; float* rowss; bf16_t* halo; int halomode; const float* cw; const float* cbias; int rspace, Mrows;
    __device__ __forceinline__ void row_op(f32x4 a00, f32x4 a01, f32x4 a10, f32x4 a11, const int r, const int col0, const int pn, const int fq) const {
        float ss = 0.f, rs = 1.f;
        if (mode == 3) rs = rsqrtf(rowss[r] * (1.f / 2048.f) + EPS);
#pragma unroll
        for (int bj = 0; bj < 2; ++bj) {
            f32x4 v0 = bj ? a10 : a00, v1 = bj ? a11 : a01;
            const int c = col0 + bj * HALF;
            if (mode == 1 && pn == 12) {
                const int cc = c - CONVD;
                if (cc < 64) {
                    const f32x4 b0 = *(const f32x4*)(dtb + cc), b1 = *(const f32x4*)(dtb + cc + 4);
                    f32x4 o0, o1;
#pragma unroll
                    for (int e = 0; e < 4; ++e) { const float a = v0[e] + b0[e], b = v1[e] + b1[e]; o0[e] = a > 20.f ? a : __logf(1.f + __expf(a)); o1[e] = b > 20.f ? b : __logf(1.f + __expf(b)); }
                    *(f32x4*)(dt + (size_t)r * 64 + cc) = o0; *(f32x4*)(dt + (size_t)r * 64 + cc + 4) = o1;
                }
            } else {
                bf16_t* op = O + (size_t)r * ldc + c;
                if (mode == 2) {
                    const u32x4 yq = *(const u32x4*)op; float y[8]; unpack8(yq, y);
#pragma unroll
                    for (int e = 0; e < 4; ++e) { v0[e] = y[e] * siluf(v0[e]); v1[e] = y[4 + e] * siluf(v1[e]); ss += v0[e] * v0[e] + v1[e] * v1[e]; }
                }
                if (mode == 3) { v0 = v0 * rs; v1 = v1 * rs; }
                u32x4 w; w.x = cvt_pk_bf16(v0[0], v0[1]); w.y = cvt_pk_bf16(v0[2], v0[3]); w.z = cvt_pk_bf16(v1[0], v1[1]); w.w = cvt_pk_bf16(v1[2], v1[3]);
                *(u32x4*)op = w;
                if (halomode) {
                    const int r64 = r & 63;
                    if (halomode == 1) { if (r64 == 0 || r64 == 63) *(u32x4*)(halo + ((size_t)(r >> 6) * 2 + (r64 ? 1 : 0)) * ldc + c) = w; }
                    else { if (r64 == 0 || r64 >= 62) *(u32x4*)(halo + ((size_t)(r >> 6) * 3 + (r64 ? r64 - 61 : 0)) * ldc + c) = w; }
                }
            }
        }
        if (mode == 2) { const int ln = (r & 15) | (fq << 4); ss += shx(ss, 16, ln); ss += shx(ss, 32, ln); if (fq == 0) atomicAdd(rowss + r, ss); }
    }
    __device__ __forceinline__ void conv_epi(const f32x4 (&acc)[2][2][4][2], const Unit& u, int wr, int wc, int fr, int fq) const {
        const int lane = fr | (fq << 4);
        const int tokb = 248 * u.pm - 1 + 62 * wr + 4 * fr;
        const int colh = 128 * u.pn + 32 * wc + 8 * fq;
        unsigned fvalid = 0u, fstart = 0u, fend = 0u;
#pragma unroll
        for (int q = 0; q < 8; ++q) { const int m = q & 3, tok = tokb + 124 * (q >> 2) + m;
            const bool valid = !(fr == 0 && m == 0) && !(fr == 15 && m == 3) && tok >= 0 && tok < Mrows;
            bool sstart, send;
            if (rspace) { const int j = tok % RPB; sstart = (j == 0) || (j == CTXL); send = (j == CTXL - 1) || (j == RPB - 1); }
            else { const int j = tok & (SEQ - 1); sstart = (j == 0); send = (j == SEQ - 1); }
            fvalid |= (valid ? 1u : 0u) << q; fstart |= (sstart ? 1u : 0u) << q; fend |= (send ? 1u : 0u) << q; }
#pragma unroll
        for (int n = 0; n < 2; ++n) {
            float wv[4][3], wg[4][3], bv[4], bg[4];
#pragma unroll
            for (int e = 0; e < 4; ++e) { const int c = colh + 4 * n + e;
#pragma unroll
                for (int k = 0; k < 3; ++k) { wv[e][k] = cw[c * 3 + k]; wg[e][k] = cw[(DFF + c) * 3 + k]; }
                bv[e] = cbias[c]; bg[e] = cbias[DFF + c]; }
#pragma unroll
            for (int ai = 0; ai < 2; ++ai) {
                f32x4 pv, pg, nv, ng;
#pragma unroll
                for (int e = 0; e < 4; ++e) { pv[e] = shx(acc[ai][0][3][n][e], 0, lane - 1); pg[e] = shx(acc[ai][1][3][n][e], 0, lane - 1);
                    nv[e] = shx(acc[ai][0][0][n][e], 0, lane + 1); ng[e] = shx(acc[ai][1][0][n][e], 0, lane + 1); }
#pragma unroll
                for (int m = 0; m < 4; ++m) {
                    const int q = 4 * ai + m, tok = tokb + 124 * ai + m;
                    const bool valid = (fvalid >> q) & 1u, sstart = (fstart >> q) & 1u, send = (fend >> q) & 1u;
                    const f32x4 uv = acc[ai][0][m][n], ug = acc[ai][1][m][n];
                    const f32x4 qv = (m == 0) ? pv : acc[ai][0][m > 0 ? m - 1 : 0][n], qg = (m == 0) ? pg : acc[ai][1][m > 0 ? m - 1 : 0][n];
                    const f32x4 rv = (m == 3) ? nv : acc[ai][0][m < 3 ? m + 1 : 3][n], rg = (m == 3) ? ng : acc[ai][1][m < 3 ? m + 1 : 3][n];
                    float h[4];
#pragma unroll
                    for (int e = 0; e < 4; ++e) {
                        float val = bv[e] + wv[e][1] * uv[e], gt = bg[e] + wg[e][1] * ug[e];
                        val += sstart ? 0.f : wv[e][0] * qv[e]; gt += sstart ? 0.f : wg[e][0] * qg[e];
                        val += send ? 0.f : wv[e][2] * rv[e]; gt += send ? 0.f : wg[e][2] * rg[e];
                        h[e] = siluf(gt) * val; }
                    if (valid) { u32x2 w; w.x = cvt_pk_bf16(h[0], h[1]); w.y = cvt_pk_bf16(h[2], h[3]); *(u32x2*)(O + (size_t)tok * ldc + colh + 4 * n) = w; }
                }
            }
        }
    }
    __device__ __forceinline__ void convs_epi(const f32x4 (&acc)[2][2][4][2], const Unit& u, int wr, int wc, int fr, int fq) const {
        const int lane = fr | (fq << 4);
        const int tokb = 250 * u.pm - 2 + 125 * wr + 8 * fr;
        if (u.pn == 12) {
            const int cc = 32 * wc + 8 * fq;
            if (cc < 64) {
#pragma unroll
                for (int q = 0; q < 8; ++q) { const int tb = 8 * fr + q, tok = tokb + q;
                    if (tb >= 2 && tb <= 126 && tok >= 0 && tok < Mrows) {
#pragma unroll
                        for (int n = 0; n < 2; ++n) { const f32x4 v = acc[q >> 2][0][q & 3][n]; const f32x4 b4 = *(const f32x4*)(dtb + cc + 4 * n); f32x4 o;
#pragma unroll
                            for (int e = 0; e < 4; ++e) { const float a = v[e] + b4[e]; o[e] = a > 20.f ? a : __logf(1.f + __expf(a)); }
                            *(f32x4*)(dt + (size_t)tok * 64 + cc + 4 * n) = o; } } }
            }
            return;
        }
        unsigned fvalid = 0u, fs0 = 0u, fs1 = 0u, fse = 0u;
#pragma unroll
        for (int q = 0; q < 8; ++q) { const int tb = 8 * fr + q, tok = tokb + q; const int j = tok % RPB;
            fvalid |= ((tb >= 2 && tb <= 126 && tok >= 0 && tok < Mrows) ? 1u : 0u) << q;
            fs0 |= (((j == 0) || (j == CTXL)) ? 1u : 0u) << q; fs1 |= (((j == 1) || (j == CTXL + 1)) ? 1u : 0u) << q; fse |= (((j == CTXL - 1) || (j == RPB - 1)) ? 1u : 0u) << q; }
#pragma unroll
        for (int bj = 0; bj < 2; ++bj)
#pragma unroll
            for (int n = 0; n < 2; ++n) {
                const int c0 = u.pn * BM + bj * HALF + wc * 32 + 8 * fq + 4 * n;
                float w[4][4], bb[4];
#pragma unroll
                for (int e = 0; e < 4; ++e) { const f32x4 q4 = *(const f32x4*)(cw + (size_t)(c0 + e) * 4); w[e][0] = q4.x; w[e][1] = q4.y; w[e][2] = q4.z; w[e][3] = q4.w; bb[e] = cbias[c0 + e]; }
                f32x4 p2, p3, nx;
#pragma unroll
                for (int e = 0; e < 4; ++e) { p2[e] = shx(acc[1][bj][2][n][e], 0, lane - 1); p3[e] = shx(acc[1][bj][3][n][e], 0, lane - 1); nx[e] = shx(acc[0][bj][0][n][e], 0, lane + 1); }
#pragma unroll
                for (int q = 0; q < 8; ++q) {
                    const int tok = tokb + q;
                    const bool valid = (fvalid >> q) & 1u, s0 = (fs0 >> q) & 1u, s1 = (fs1 >> q) & 1u, se = (fse >> q) & 1u;
                    const f32x4 u0 = acc[q >> 2][bj][q & 3][n];
                    const f32x4 um2 = q >= 2 ? acc[(q >= 2 ? q - 2 : 0) >> 2][bj][(q >= 2 ? q - 2 : 0) & 3][n] : (q == 0 ? p2 : p3);
                    const f32x4 um1 = q >= 1 ? acc[(q >= 1 ? q - 1 : 0) >> 2][bj][(q >= 1 ? q - 1 : 0) & 3][n] : p3;
                    const f32x4 up1 = q <= 6 ? acc[(q <= 6 ? q + 1 : 7) >> 2][bj][(q <= 6 ? q + 1 : 7) & 3][n] : nx;
                    float o[4];
#pragma unroll
                    for (int e = 0; e < 4; ++e) { float a = bb[e] + w[e][2] * u0[e];
                        a += (s0 || s1) ? 0.f : w[e][0] * um2[e]; a += s0 ? 0.f : w[e][1] * um1[e]; a += se ? 0.f : w[e][3] * up1[e]; o[e] = siluf(a); }
                    if (valid) { u32x2 pk; pk.x = cvt_pk_bf16(o[0], o[1]); pk.y = cvt_pk_bf16(o[2], o[3]); *(u32x2*)(O + (size_t)tok * ldc + c0) = pk; }
                }
            }
    }
    __device__ __forceinline__ void operator()(const f32x4 (&acc)[2][2][4][2], const Unit& u, int wr, int wc, int fr, int fq) const {
        if (mode == 4) { conv_epi(acc, u, wr, wc, fr, fq); return; }
        if (mode == 5) { convs_epi(acc, u, wr, wc, fr, fq); return; }
        const int row0 = u.pm * BM + wr * 64 + fr, col0 = u.pn * BM + wc * 32 + 8 * fq;
#define EPI_ROW(ai, m) row_op(acc[ai][0][m][0], acc[ai][0][m][1], acc[ai][1][m][0], acc[ai][1][m][1], row0 + (ai) * HALF + (m) * 16, col0, u.pn, fq)
        EPI_ROW(0, 0); EPI_ROW(0, 1); EPI_ROW(0, 2); EPI_ROW(0, 3); EPI_ROW(1, 0); EPI_ROW(1, 1); EPI_ROW(1, 2); EPI_ROW(1, 3);
#undef EPI_ROW
    }
};

template <class Epi, class Sched>
__device__ __forceinline__ void gemm_phase(LAS unsigned char* lds, const Gemm g, const Sched& S, const Epi& E, const int tidx_) {
    const int tid = tidx_, wid = __builtin_amdgcn_readfirstlane(tid >> 6), lane = tid & 63, wr = wid >> 2, wc = wid & 3, fr = lane & 15, fq = lane >> 4;
    const int K = g.K, nt = K / BK, lda = g.lda;
    unsigned voffA[2], voffB[2];
#pragma unroll
    for (int i = 0; i < 2; ++i) { int R, C; stage_rc(tid * 16 + i * 8192, R, C); const int Rb = Epi::PERM ? ((R & ~31) + perm32(R & 31)) : R;
        const int Ra = g.cmode == 1 ? 62 * (R >> 6) + 4 * (R & 15) + ((R >> 4) & 3)
                     : g.cmode == 2 ? 125 * (R >> 6) + 8 * (R & 15) + ((R >> 4) & 3) : R;
        voffA[i] = (unsigned)(Ra * lda + C) * 2u; voffB[i] = (unsigned)(Rb * K + C) * 2u; }
    const size_t kstep = (size_t)(BK * 2);
    const size_t hstepA = (size_t)(g.cmode == 1 ? 124 : g.cmode == 2 ? 4 : HALF) * lda * 2, hstepB = (size_t)HALF * K * 2;
    const char* Abase = (const char*)g.A - (size_t)g.cmode * lda * 2;
    const size_t tstepA = (size_t)(g.cmode == 1 ? 248 : g.cmode == 2 ? 250 : BM) * lda * 2, tstepB = 2 * hstepB;
    const unsigned ldsw = (unsigned)wid * 1024u;
    const int aoff = lds_byte(wr * 64 + fr, fq * 8), boff = lds_byte(wc * 32 + fr, fq * 8);
#define PG8_SA(b, h) (((b) * 2 + (h)) * HTB)
#define PG8_SB(b, h) ((4 + (b) * 2 + (h)) * HTB)
#define PG8_STAGE(bufoff, gbase, voff) do { _Pragma("unroll") for (int _i = 0; _i < 2; ++_i) \
        __builtin_amdgcn_global_load_lds((const unsigned*)((const char*)(gbase) + (voff)[_i]), (LAS unsigned*)(lds + (bufoff) + ldsw + _i * 8192), 16, 0, 0); } while (0)
#define PG8_LDA(dst, b, h) do { _Pragma("unroll") for (int m = 0; m < 4; ++m) _Pragma("unroll") for (int k = 0; k < 2; ++k) dst[m][k] = *(const LAS bf16x8*)(lds + PG8_SA(b, h) + aoff + m * 2048 + k * 1024); } while (0)
#define PG8_LDB(dst, b, h) do { _Pragma("unroll") for (int n = 0; n < 2; ++n) _Pragma("unroll") for (int k = 0; k < 2; ++k) dst[n][k] = *(const LAS bf16x8*)(lds + PG8_SB(b, h) + boff + n * 2048 + k * 1024); } while (0)
#define PG8_MMA(ai, bj, At, Bt) do { __builtin_amdgcn_s_setprio(1); _Pragma("unroll") for (int m = 0; m < 4; ++m) _Pragma("unroll") for (int n = 0; n < 2; ++n) _Pragma("unroll") for (int k = 0; k < 2; ++k) \
        acc[ai][bj][m][n] = __builtin_amdgcn_mfma_f32_16x16x32_bf16(Bt[n][k], At[m][k], acc[ai][bj][m][n], 0, 0, 0); __builtin_amdgcn_s_setprio(0); } while (0)
#define PG8_WAIT_V(n) asm volatile("s_waitcnt vmcnt(" #n ")" ::: "memory")
#define PG8_WAIT_L(n) asm volatile("s_waitcnt lgkmcnt(" #n ")" ::: "memory")
#define PG8_BAR __builtin_amdgcn_s_barrier()
#define PG8_SCHED __builtin_amdgcn_sched_barrier(0)
    Unit cur, nxt; int ui = 0;
    if (!S.next(0, cur)) return;
    f32x4 acc[2][2][4][2];
#pragma unroll
    for (int a = 0; a < 2; ++a)
#pragma unroll
        for (int b = 0; b < 2; ++b)
#pragma unroll
            for (int m = 0; m < 4; ++m)
#pragma unroll
                for (int n = 0; n < 2; ++n) acc[a][b][m][n] = (f32x4){0.f, 0.f, 0.f, 0.f};
    bf16x8 At[4][2], B0[2][2], B1[2][2];
    const char* cA = Abase + (size_t)tile_a(g, cur.pm) * tstepA; const char* cB = (const char*)g.Bt + (size_t)cur.pn * tstepB;
    PG8_STAGE(PG8_SB(0, 0), cB, voffB); PG8_STAGE(PG8_SB(0, 1), cB + hstepB, voffB); PG8_STAGE(PG8_SA(0, 0), cA, voffA); PG8_STAGE(PG8_SA(0, 1), cA + hstepA, voffA);
    if (wr == 1) PG8_BAR;
    PG8_WAIT_V(2); PG8_BAR;
    PG8_STAGE(PG8_SB(1, 0), cB + kstep, voffB); PG8_STAGE(PG8_SA(1, 0), cA + kstep, voffA); PG8_STAGE(PG8_SB(1, 1), cB + hstepB + kstep, voffB);
    PG8_WAIT_V(6); PG8_BAR;
    for (;;) {
        const bool has_next = S.next(ui + 1, nxt);
        const char* nA = has_next ? Abase + (size_t)tile_a(g, nxt.pm) * tstepA : cA; const char* nB = has_next ? (const char*)g.Bt + (size_t)nxt.pn * tstepB : cB;
        for (int t = 0; t < nt; t += 2) {
            const bool last = (t == nt - 2);
            const char* a1 = cA + (size_t)(t + 1) * kstep;
            const char* a2 = last ? nA : cA + (size_t)(t + 2) * kstep; const char* b2 = last ? nB : cB + (size_t)(t + 2) * kstep;
            const char* a3 = a2 + kstep; const char* b3 = b2 + kstep;
            PG8_LDB(B0, 0, 0); PG8_LDB(B1, 0, 1); PG8_SCHED; PG8_LDA(At, 0, 0); PG8_STAGE(PG8_SA(1, 1), a1 + hstepA, voffA);
            PG8_WAIT_V(8); PG8_WAIT_L(0); PG8_BAR; PG8_MMA(0, 0, At, B0); PG8_MMA(0, 1, At, B1); PG8_BAR; PG8_SCHED;
            PG8_LDA(At, 0, 1); PG8_STAGE(PG8_SB(0, 0), b2, voffB); PG8_STAGE(PG8_SB(0, 1), b2 + hstepB, voffB); PG8_STAGE(PG8_SA(0, 0), a2, voffA);
            PG8_WAIT_V(8); PG8_WAIT_L(0); PG8_BAR; PG8_MMA(1, 0, At, B0); PG8_MMA(1, 1, At, B1); PG8_BAR; PG8_SCHED;
            PG8_LDB(B0, 1, 0); PG8_LDB(B1, 1, 1); PG8_SCHED; PG8_LDA(At, 1, 0); PG8_STAGE(PG8_SA(0, 1), a2 + hstepA, voffA);
            PG8_WAIT_V(8); PG8_WAIT_L(0); PG8_BAR; PG8_MMA(0, 0, At, B0); PG8_MMA(0, 1, At, B1); PG8_BAR; PG8_SCHED;
            PG8_LDA(At, 1, 1); PG8_STAGE(PG8_SB(1, 0), b3, voffB); PG8_STAGE(PG8_SB(1, 1), b3 + hstepB, voffB); PG8_STAGE(PG8_SA(1, 0), a3, voffA);
            PG8_WAIT_V(8); PG8_WAIT_L(0); PG8_BAR; PG8_MMA(1, 0, At, B0); PG8_MMA(1, 1, At, B1); PG8_BAR; PG8_SCHED;
        }
        if (wr == 0) PG8_BAR;
        E(acc, cur, wr, wc, fr, fq);
        if (!has_next) break;
#pragma unroll
        for (int a = 0; a < 2; ++a)
#pragma unroll
            for (int b = 0; b < 2; ++b)
#pragma unroll
                for (int m = 0; m < 4; ++m)
#pragma unroll
                    for (int n = 0; n < 2; ++n) acc[a][b][m][n] = (f32x4){0.f, 0.f, 0.f, 0.f};
        cur = nxt; cA = nA; cB = nB; ++ui;
        if (wr == 1) PG8_BAR;
    }
    PG8_WAIT_V(0);
    PG8_BAR;
#undef PG8_SA
#undef PG8_SB
#undef PG8_STAGE
#undef PG8_LDA
#undef PG8_LDB
#undef PG8_MMA
#undef PG8_WAIT_V
#undef PG8_WAIT_L
#undef PG8_BAR
#undef PG8_SCHED
}
}

namespace att {
constexpr int D = 128, NW = 8, QBLK = 32, KVBLK = 64;
constexpr float SCALE = 0.088388347648318440f;
constexpr float THR = 8.f;
constexpr int LDQ = INA, LDK = INA, LDO = DM;
constexpr size_t SHM_V = KVBLK * D * 2, SHM_K = KVBLK * D * 2;
#define KSWZ(row, colB) ((row) * 256 + ((colB) ^ (((row) & 7) << 4)))
#define SBAR() __builtin_amdgcn_sched_barrier(0)
__device__ __forceinline__ int crow(int r, int hi) { return (r & 3) + 8 * (r >> 2) + 4 * hi; }
__device__ __forceinline__ void partialSM(f32x16& p0, f32x16& p1, float& m_reg, float& mn, float& alpha) {
    constexpr float C = SCALE * 1.4426950408889634f;
    float pmax = p0[0];
#pragma unroll
    for (int r = 1; r < 16; ++r) pmax = fmaxf(pmax, p0[r]);
#pragma unroll
    for (int r = 0; r < 16; ++r) pmax = fmaxf(pmax, p1[r]);
    { auto rr = __builtin_amdgcn_permlane32_swap(__float_as_uint(pmax), __float_as_uint(pmax), false, false);
      pmax = fmaxf(__uint_as_float(rr[0]), __uint_as_float(rr[1])); }
    if (__builtin_expect(__all(pmax - m_reg <= THR / SCALE), 1)) { mn = m_reg; alpha = 1.f; }
    else { mn = fmaxf(m_reg, pmax); alpha = __builtin_amdgcn_exp2f((m_reg - mn) * C); m_reg = mn; }
    float mnC = -mn * C;
#pragma unroll
    for (int r = 0; r < 16; ++r) p0[r] = fmaf(p0[r], C, mnC);
#pragma unroll
    for (int r = 0; r < 16; ++r) p1[r] = fmaf(p1[r], C, mnC);
#pragma unroll
    for (int r = 0; r < 16; ++r) p0[r] = __builtin_amdgcn_exp2f(p0[r]);
}
#define PK4(P, BASE, OUT) do { unsigned a0 = cvt_pk_bf16(P[BASE + 0], P[BASE + 1]), a1 = cvt_pk_bf16(P[BASE + 2], P[BASE + 3]);   \
    unsigned b0 = cvt_pk_bf16(P[BASE + 4], P[BASE + 5]), b1 = cvt_pk_bf16(P[BASE + 6], P[BASE + 7]);                              \
    auto r0 = __builtin_amdgcn_permlane32_swap(a0, b0, false, false); auto r1 = __builtin_amdgcn_permlane32_swap(a1, b1, false, false); \
    u32x4 w = {r0[0], r1[0], r0[1], r1[1]}; OUT = *reinterpret_cast<bf16x8*>(&w); } while (0)
__device__ __forceinline__ void finishSM(f32x16& p0, f32x16& p1, float alpha, float& l_reg, bf16x8& pa0, bf16x8& pa1, bf16x8& pa2, bf16x8& pa3) {
#pragma unroll
    for (int r = 0; r < 16; ++r) p1[r] = __builtin_amdgcn_exp2f(p1[r]);
    float ps = 0;
#pragma unroll
    for (int r = 0; r < 16; ++r) ps += p0[r];
#pragma unroll
    for (int r = 0; r < 16; ++r) ps += p1[r];
    { auto rr = __builtin_amdgcn_permlane32_swap(__float_as_uint(ps), __float_as_uint(ps), false, false);
      ps = __uint_as_float(rr[0]) + __uint_as_float(rr[1]); }
    l_reg = l_reg * alpha + ps;
    PK4(p0, 0, pa0); PK4(p0, 8, pa1); PK4(p1, 0, pa2); PK4(p1, 8, pa3);
}
__device__ __forceinline__ void qkt(f32x16& p0, f32x16& p1, const bf16_t* Ks, const bf16x8* qr, int r32, int hi) {
    p0 = f32x16{}; p1 = f32x16{};
#pragma unroll
    for (int d0 = 0; d0 < 8; ++d0) { int cb = (d0 * 16 + hi * 8) * 2;
        bf16x8 b0 = *reinterpret_cast<const bf16x8*>((const char*)Ks + KSWZ(r32, cb));
        bf16x8 b1 = *reinterpret_cast<const bf16x8*>((const char*)Ks + KSWZ(32 + r32, cb));
        p0 = __builtin_amdgcn_mfma_f32_32x32x16_bf16(b0, qr[d0], p0, 0, 0, 0);
        p1 = __builtin_amdgcn_mfma_f32_32x32x16_bf16(b1, qr[d0], p1, 0, 0, 0); }
}
__device__ __forceinline__ int v_st(int k, int c) { const int kk = (k & ~0xC) | ((k & 4) << 1) | ((k & 8) >> 1); return ((kk >> 3) * 4 + (c >> 5)) * 512 + ((kk & 7) * 32 + (c & 31)) * 2; }
__device__ __forceinline__ int v_rd_base(int lane) { return ((lane & 3) << 3) | (((lane >> 2) & 3) << 6) | (((lane >> 4) & 1) << 5) | (((lane >> 5) & 1) << 8); }
constexpr int v_rd_off(int d0, int ks, int half) { return d0 * 512 + ks * 4096 + half * 2048; }
template <int OFF> __device__ __forceinline__ s16x4 tr_read(int vb) {
    s16x4 r; asm volatile("ds_read_b64_tr_b16 %0, %1 offset:%2" : "=&v"(r) : "v"(vb), "i"(OFF) : "memory"); return r;
}
template <int D0> __device__ __forceinline__ void pv_one(f32x16& od, int vb, bf16x8 pa0, bf16x8 pa1, bf16x8 pa2, bf16x8 pa3) {
    const s16x4 l0 = tr_read<v_rd_off(D0, 0, 0)>(vb), h0 = tr_read<v_rd_off(D0, 0, 1)>(vb), l1 = tr_read<v_rd_off(D0, 1, 0)>(vb), h1 = tr_read<v_rd_off(D0, 1, 1)>(vb);
    const s16x4 l2 = tr_read<v_rd_off(D0, 2, 0)>(vb), h2 = tr_read<v_rd_off(D0, 2, 1)>(vb), l3 = tr_read<v_rd_off(D0, 3, 0)>(vb), h3 = tr_read<v_rd_off(D0, 3, 1)>(vb);
    asm volatile("s_waitcnt lgkmcnt(0)" ::: "memory"); SBAR();
#define PKV(L, H) (bf16x8){L[0], L[1], L[2], L[3], H[0], H[1], H[2], H[3]}
    od = __builtin_amdgcn_mfma_f32_32x32x16_bf16(pa0, PKV(l0, h0), od, 0, 0, 0);
    od = __builtin_amdgcn_mfma_f32_32x32x16_bf16(pa1, PKV(l1, h1), od, 0, 0, 0);
    od = __builtin_amdgcn_mfma_f32_32x32x16_bf16(pa2, PKV(l2, h2), od, 0, 0, 0);
    od = __builtin_amdgcn_mfma_f32_32x32x16_bf16(pa3, PKV(l3, h3), od, 0, 0, 0);
#undef PKV
}
__device__ __forceinline__ void pv_d0(f32x16* o, int vb, bf16x8 pa0, bf16x8 pa1, bf16x8 pa2, bf16x8 pa3) {
    pv_one<0>(o[0], vb, pa0, pa1, pa2, pa3); pv_one<1>(o[1], vb, pa0, pa1, pa2, pa3); pv_one<2>(o[2], vb, pa0, pa1, pa2, pa3); pv_one<3>(o[3], vb, pa0, pa1, pa2, pa3);
}

__device__ __forceinline__ void attn_dense_body(const bf16_t* __restrict__ Qb, const bf16_t* __restrict__ Kh, const bf16_t* __restrict__ Vh,
                                                bf16_t* __restrict__ Ob, int seq, char* lds, const int tidx_) {
    const int tid = tidx_, wid = tid >> 6, lane = tid & 63, r32 = lane & 31, hi = lane >> 5;
    bf16_t* V_lds = (bf16_t*)lds; bf16_t* K_lds = (bf16_t*)(lds + 2 * SHM_V);
    float* ws = (float*)(lds + 2 * SHM_V + 2 * SHM_K) + wid * 64; float* li_l = ws; float* al_l = ws + 32;
    float m_reg = -1e30f, l_reg = 0; f32x16 o[4] = {}; bf16x8 qr[8];
    const bf16_t* Qw = Qb + (long)(wid * QBLK + r32) * LDQ + hi * 8;
#pragma unroll
    for (int d0 = 0; d0 < 8; ++d0) qr[d0] = *reinterpret_cast<const bf16x8*>(Qw + d0 * 16);
    const int sr = tid >> 4, sc = (tid & 15) * 8, vst0 = v_st(sr, sc), vst1 = v_st(32 + sr, sc);
    const int vb0 = (int)(uintptr_t)V_lds + v_rd_base(lane);
    struct { bf16x8 vs0, vs1, ks0, ks1; } sr_[2];
    const unsigned rowoff = (unsigned)(sr * LDK + sc) * 2u;
#define SLOAD(i, k0) do { const unsigned o_ = rowoff + (unsigned)(k0) * (unsigned)(LDK * 2); \
    sr_[i].vs0 = *reinterpret_cast<const bf16x8*>((const char*)Vh + o_); sr_[i].vs1 = *reinterpret_cast<const bf16x8*>((const char*)Vh + o_ + 32u * LDK * 2u); \
    sr_[i].ks0 = *reinterpret_cast<const bf16x8*>((const char*)Kh + o_); sr_[i].ks1 = *reinterpret_cast<const bf16x8*>((const char*)Kh + o_ + 32u * LDK * 2u); } while (0)
#define SWRITE(b, i) do { *(bf16x8*)((char*)V_lds + (b) * SHM_V + vst0) = sr_[i].vs0;          \
    *(bf16x8*)((char*)V_lds + (b) * SHM_V + vst1) = sr_[i].vs1; int kc = sc * 2;               \
    *(bf16x8*)((char*)K_lds + (b) * SHM_K + KSWZ(sr, kc)) = sr_[i].ks0;                       \
    *(bf16x8*)((char*)K_lds + (b) * SHM_K + KSWZ(32 + sr, kc)) = sr_[i].ks1; } while (0)
#define SWAIT() asm volatile("s_waitcnt vmcnt(4)" ::: "memory")
#define RESC(a) do { if (__any((a) < 1.f)) { if (hi == 0) al_l[r32] = (a); asm volatile("s_waitcnt lgkmcnt(0)" ::: "memory"); \
    _Pragma("unroll") for (int d = 0; d < 4; ++d) _Pragma("unroll") for (int r = 0; r < 16; ++r) o[d][r] *= al_l[crow(r, hi)]; } } while (0)
    f32x16 pA0, pA1, pB0, pB1; float mnA, mnB, alA, alB; bf16x8 pa0, pa1, pa2, pa3; const int NT = seq / KVBLK;
    constexpr int SE = 0, SO = 1;
    SLOAD(SE, 0); asm volatile("s_waitcnt vmcnt(0)" ::: "memory"); SWRITE(0, SE); __syncthreads();
    qkt(pA0, pA1, K_lds, qr, r32, hi); partialSM(pA0, pA1, m_reg, mnA, alA);
    SLOAD(SO, KVBLK); if (2 < NT) SLOAD(SE, 2 * KVBLK);
    SWAIT(); SWRITE(1, SO); __syncthreads();
    for (int j = 1; j + 1 < NT; j += 2) {
        SBAR(); qkt(pB0, pB1, (bf16_t*)((char*)K_lds + SHM_K), qr, r32, hi);
        finishSM(pA0, pA1, alA, l_reg, pa0, pa1, pa2, pa3); SBAR();
        SLOAD(SO, (j + 2) * KVBLK); SBAR();
        pv_d0(o, vb0, pa0, pa1, pa2, pa3); partialSM(pB0, pB1, m_reg, mnB, alB);
        __syncthreads(); SWAIT(); SWRITE(0, SE);
        RESC(alB); __syncthreads();
        SBAR(); qkt(pA0, pA1, K_lds, qr, r32, hi);
        finishSM(pB0, pB1, alB, l_reg, pa0, pa1, pa2, pa3); SBAR();
        if (j + 3 < NT) SLOAD(SE, (j + 3) * KVBLK); SBAR();
        pv_d0(o, vb0 + (int)SHM_V, pa0, pa1, pa2, pa3); partialSM(pA0, pA1, m_reg, mnA, alA);
        __syncthreads(); SWAIT(); SWRITE(1, SO);
        RESC(alA); __syncthreads();
    }
    SBAR(); qkt(pB0, pB1, (bf16_t*)((char*)K_lds + SHM_K), qr, r32, hi);
    finishSM(pA0, pA1, alA, l_reg, pa0, pa1, pa2, pa3); SBAR();
    pv_d0(o, vb0, pa0, pa1, pa2, pa3); partialSM(pB0, pB1, m_reg, mnB, alB);
    __syncthreads(); RESC(alB);
    finishSM(pB0, pB1, alB, l_reg, pa0, pa1, pa2, pa3); SBAR();
    pv_d0(o, vb0 + (int)SHM_V, pa0, pa1, pa2, pa3);
    if (hi == 0) li_l[r32] = l_reg; asm volatile("s_waitcnt lgkmcnt(0)" ::: "memory");
    float rli[16];
#pragma unroll
    for (int r = 0; r < 16; ++r) rli[r] = __builtin_amdgcn_rcpf(li_l[crow(r, hi)]);
    bf16_t* Ow = Ob + (long)(wid * QBLK) * LDO;
#pragma unroll
    for (int r = 0; r < 16; ++r) { int orow = crow(r, hi);
#pragma unroll
        for (int d0 = 0; d0 < 4; ++d0) Ow[(long)orow * LDO + d0 * 32 + r32] = (bf16_t)(cvt_pk_bf16(o[d0][r] * rli[r], 0.f) & 0xffffu); }
#undef SLOAD
#undef SWRITE
#undef SWAIT
#undef RESC
}
}

__device__ __forceinline__ void p0_transpose_item(const float* W, int K, int N, bf16_t* WT, LAS float* scr, int item, int lane, const float* kscale, int ileave = 0) {
    const int nblk = N / 32, kb = item / nblk, nb = item % nblk, k0 = 64 * kb, n0 = 32 * nb;
    const int d0 = !ileave ? n0 : (n0 < DFF ? 256 * (n0 >> 7) + (n0 & 127) : 256 * ((n0 - DFF) >> 7) + 128 + ((n0 - DFF) & 127));
#pragma unroll 8
    for (int i = 0; i < 32; ++i) { const int kk = 2 * i + (lane >> 5); float v = W[(size_t)(k0 + kk) * N + n0 + (lane & 31)]; if (kscale) v *= kscale[k0 + kk]; scr[kk * 33 + (lane & 31)] = v; }
    asm volatile("s_waitcnt lgkmcnt(0)" ::: "memory");
    const int c = lane & 7;
#pragma unroll
    for (int j = 0; j < 4; ++j) { const int n = (lane >> 3) + 8 * j; const LAS float* s = scr + (8 * c) * 33 + n;
        u32x4 o; o.x = cvt_pk_bf16(s[0 * 33], s[1 * 33]); o.y = cvt_pk_bf16(s[2 * 33], s[3 * 33]); o.z = cvt_pk_bf16(s[4 * 33], s[5 * 33]); o.w = cvt_pk_bf16(s[6 * 33], s[7 * 33]);
        *(u32x4*)(WT + (size_t)(d0 + n) * K + k0 + 8 * c) = o; }
    asm volatile("s_waitcnt lgkmcnt(0)" ::: "memory");
}

__device__ __forceinline__ void phase_p0(KP P, LAS unsigned char* lds, int G, const int tidx_, const int bidx_) {
    const int tid = tidx_, wid = __builtin_amdgcn_readfirstlane(tid >> 6), lane = tid & 63;
    unsigned char* ws = P->ws;
    {
        LAS float* SC = (LAS float*)lds;
        LAS float* RED = (LAS float*)(lds + 36864);
        bool have = false;
        for (int task = bidx_; task < 192; task += G) {
            if (!have) {
                for (int idx = tid; idx < 9 * 1024; idx += 512) { const int row = idx >> 10, k = idx & 1023; const float v = row < 8 ? P->in[I_C][row * 1024 + k] : P->in[I_CCTX][k]; SC[idx] = v / (1.f + expf(-v)); }
                __syncthreads(); have = true;
            }
            const int layer = task / 96, n0 = (task % 96) * 64;
            const float* W = P->in[I_ADAW] + (size_t)layer * 1024 * 6144 + n0 + lane;
            float a[9];
#pragma unroll
            for (int r = 0; r < 9; ++r) a[r] = 0.f;
            const int kbeg = wid * 128;
#pragma unroll 8
            for (int k = 0; k < 128; ++k) { const float w = W[(size_t)(kbeg + k) * 6144];
#pragma unroll
                for (int r = 0; r < 9; ++r) a[r] += SC[r * 1024 + kbeg + k] * w; }
#pragma unroll
            for (int r = 0; r < 9; ++r) RED[(wid * 9 + r) * 64 + lane] = a[r];
            __syncthreads();
            for (int idx = tid; idx < 576; idx += 512) { const int r = idx >> 6, l = idx & 63; float s = P->in[I_ADAB][layer * 6144 + n0 + l];
#pragma unroll
                for (int w = 0; w < 8; ++w) s += RED[(w * 9 + r) * 64 + l];
                ((float*)(ws + WS_MOD))[(layer * 9 + r) * 6144 + n0 + l] = s; }
            __syncthreads();
        }
        __syncthreads();
    }
    {
        const int gt = bidx_ * 512 + tid, NT = G * 512;
        float* rs = (float*)(ws + WS_ROWSS);
        for (int i = gt; i < MT; i += NT) rs[i] = 0.f;
        u32x4* pz = (u32x4*)(ws + W_SIN + (size_t)INC * 1024 * 2);
        for (int i = gt; i < (SINP - INC) * 1024 / 8; i += NT) pz[i] = (u32x4){0u, 0u, 0u, 0u};
    }
    {
        LAS float* scr = (LAS float*)(lds + wid * 8448);
        const int gw = bidx_ * 8 + wid, NGW = G * 8;
        constexpr int I0 = 16 * 48, I1 = 16 * 32, I2 = 16 * 176, I3 = 44 * 32, I4 = 16 * 162, I5 = 32 * 32;
        constexpr int NIT = I0 + I1 + 2 * I2 + 2 * I3 + I4 + I5;
        for (int it = gw; it < NIT; it += NGW) {
            int r = it;
            if (r < I0) { p0_transpose_item(P->in[I_AWIN], 1024, INA, (bf16_t*)(ws + W_AIN), scr, r, lane, nullptr); continue; } r -= I0;
            if (r < I1) { p0_transpose_item(P->in[I_AWOUT], 1024, 1024, (bf16_t*)(ws + W_AOUT), scr, r, lane, nullptr); continue; } r -= I1;
            if (r < I2) { p0_transpose_item(P->in[I_FUP], 1024, DFF2, (bf16_t*)(ws + W_UP0), scr, r, lane, nullptr, 1); continue; } r -= I2;
            if (r < I2) { p0_transpose_item(P->in[I_FUP] + (size_t)1024 * DFF2, 1024, DFF2, (bf16_t*)(ws + W_UP1), scr, r, lane, nullptr, 1); continue; } r -= I2;
            if (r < I3) { p0_transpose_item(P->in[I_FDN], DFF, 1024, (bf16_t*)(ws + W_DN0), scr, r, lane, nullptr); continue; } r -= I3;
            if (r < I3) { p0_transpose_item(P->in[I_FDN] + (size_t)DFF * 1024, DFF, 1024, (bf16_t*)(ws + W_DN1), scr, r, lane, nullptr); continue; } r -= I3;
            if (r < I4) { p0_transpose_item(P->in[I_SWIN], 1024, INC, (bf16_t*)(ws + W_SIN), scr, r, lane, nullptr); continue; } r -= I4;
            p0_transpose_item(P->in[I_SWOUT], DIN, 1024, (bf16_t*)(ws + W_SOUT), scr, r, lane, P->in[I_SNW]);
        }
    }
}

struct RwDesc { int rows, rspace, layer, layerB; const float* srcL; const float* srcC; const bf16_t* xsrc; bf16_t* xdst; float* odst; const bf16_t* Y; const float* nwA; int gate_k; const float* nwB; int shift_k, scale_k; bf16_t* XN; };
__device__ __forceinline__ void phase_rw(KP P, const RwDesc d, int G, const int tidx_, const int bidx_) {
    const int tid = tidx_, wid = tid >> 6, lane = tid & 63;
    const int gw = bidx_ * 8 + wid, NGW = G * 8;
    const float* MOD = (const float*)(P->ws + WS_MOD) + (size_t)d.layer * 9 * 6144;
    const float* MODB = (const float*)(P->ws + WS_MOD) + (size_t)d.layerB * 9 * 6144;
    const int nk = (d.rows - gw + NGW - 1) / NGW;
    const int r0 = 0, r1 = nk;
#define RW_ROW(k_) (gw + (k_) * NGW)
#define RW_SROW(r_) (d.rspace ? (r_) : (r_) + CTXL * (((r_) >> 13) + 1))
    f32x4 vnA[4], vgt[4], vnB[4], vsh[4], vsc[4]; int cur = -1;
#pragma unroll
    for (int j = 0; j < 4; ++j) { vnA[j] = d.nwA ? *(const f32x4*)(d.nwA + 4 * lane + 256 * j) : (f32x4){0.f, 0.f, 0.f, 0.f}; vnB[j] = d.nwB ? *(const f32x4*)(d.nwB + 4 * lane + 256 * j) : (f32x4){0.f, 0.f, 0.f, 0.f}; }
#define RW_ADDR(r_, src_, mrow_) do { const int rc_ = (r_); \
        if (d.rspace) { const int b_ = rc_ / RPB, j_ = rc_ - b_ * RPB; \
            if (j_ < CTXL) { src_ = d.srcC + (size_t)(b_ * CTXL + j_) * DM; mrow_ = 8; } \
            else { src_ = d.srcL + (size_t)(b_ * SEQ + j_ - CTXL) * DM; mrow_ = b_; } \
        } else { src_ = d.srcL + (size_t)rc_ * DM; mrow_ = rc_ / SEQ; } } while (0)
#define RW_LOAD(XV, XQ, YQ, rbase_) do { _Pragma("unroll") for (int k = 0; k < 2; ++k) { const int kk_ = ((rbase_) + k < r1) ? (rbase_) + k : r1 - 1; const int rc2_ = RW_ROW(kk_); \
        if (d.xsrc) { const bf16_t* s2_ = d.xsrc + (size_t)RW_SROW(rc2_) * DM; _Pragma("unroll") for (int j = 0; j < 4; ++j) XQ[k][j] = *(const u32x2*)(s2_ + 4 * lane + 256 * j); } \
        else { const float* s_; int m_; RW_ADDR(rc2_, s_, m_); (void)m_; _Pragma("unroll") for (int j = 0; j < 4; ++j) XV[k][j] = *(const f32x4*)(s_ + 4 * lane + 256 * j); } \
        if (d.Y) { _Pragma("unroll") for (int j = 0; j < 4; ++j) YQ[k][j] = *(const u32x2*)(d.Y + (size_t)rc2_ * DM + 4 * lane + 256 * j); } } } while (0)
    f32x4 xv[2][4], xn[2][4]; u32x2 xq[2][4], xqn[2][4], yq[2][4], yn[2][4];
    if (r0 < r1) RW_LOAD(xv, xq, yq, r0);
    for (int rr = r0; rr < r1; rr += 2) {
        if (rr + 2 < r1) RW_LOAD(xn, xqn, yn, rr + 2);
#pragma unroll
        for (int k = 0; k < 2; ++k) {
            if (rr + k >= r1) continue;
            const int r = RW_ROW(rr + k);
            int mrowk;
            if (d.rspace) { const int b_ = r / RPB, j_ = r - b_ * RPB; mrowk = j_ < CTXL ? 8 : b_; } else mrowk = r / SEQ;
            if (mrowk != cur) { cur = mrowk; const float* mod = MOD + (size_t)cur * 6144; const float* modb = MODB + (size_t)cur * 6144;
#pragma unroll
                for (int j = 0; j < 4; ++j) { vgt[j] = *(const f32x4*)(mod + d.gate_k * 1024 + 4 * lane + 256 * j); vsh[j] = *(const f32x4*)(modb + d.shift_k * 1024 + 4 * lane + 256 * j);
                    vsc[j] = *(const f32x4*)(modb + d.scale_k * 1024 + 4 * lane + 256 * j); } }
            if (d.xsrc) {
#pragma unroll
                for (int j = 0; j < 4; ++j) { const u32x2 q = xq[k][j]; xv[k][j] = (f32x4){bflo(q.x), bfhi(q.x), bflo(q.y), bfhi(q.y)}; }
            }
            if (d.Y) {
                f32x4 yv[4]; float ss = 0.f;
#pragma unroll
                for (int j = 0; j < 4; ++j) { const u32x2 q = yq[k][j];
                    yv[j] = (f32x4){bflo(q.x), bfhi(q.x), bflo(q.y), bfhi(q.y)}; ss += (yv[j].x * yv[j].x + yv[j].y * yv[j].y) + (yv[j].z * yv[j].z + yv[j].w * yv[j].w); }
                const float rstd = rsqrtf(wave_sum(ss, lane) * (1.f / DM) + EPS);
#pragma unroll
                for (int j = 0; j < 4; ++j) xv[k][j] = xv[k][j] + vgt[j] * (yv[j] * rstd * vnA[j]);
                if (d.xdst) { bf16_t* xd = d.xdst + (size_t)RW_SROW(r) * DM;
#pragma unroll
                    for (int j = 0; j < 4; ++j) { u32x2 o; o.x = cvt_pk_bf16(xv[k][j].x, xv[k][j].y); o.y = cvt_pk_bf16(xv[k][j].z, xv[k][j].w); *(u32x2*)(xd + 4 * lane + 256 * j) = o; }
                }
                if (d.odst) { float* od = d.odst + (size_t)r * DM;
#pragma unroll
                    for (int j = 0; j < 4; ++j) *(f32x4*)(od + 4 * lane + 256 * j) = xv[k][j];
                }
            }
            if (d.XN) {
                float ss = 0.f;
#pragma unroll
                for (int j = 0; j < 4; ++j) ss += (xv[k][j].x * xv[k][j].x + xv[k][j].y * xv[k][j].y) + (xv[k][j].z * xv[k][j].z + xv[k][j].w * xv[k][j].w);
                const float rstd = rsqrtf(wave_sum(ss, lane) * (1.f / DM) + EPS);
#pragma unroll
                for (int j = 0; j < 4; ++j) { const f32x4 h = (xv[k][j] * rstd * vnB[j]) * (vsc[j] + 1.f) + vsh[j];
                    u32x2 o; o.x = cvt_pk_bf16(h.x, h.y); o.y = cvt_pk_bf16(h.z, h.w);
                    *(u32x2*)(d.XN + (size_t)r * DM + 4 * lane + 256 * j) = o; }
            }
        }
#pragma unroll
        for (int k = 0; k < 2; ++k)
#pragma unroll
            for (int j = 0; j < 4; ++j) { xv[k][j] = xn[k][j]; xq[k][j] = xqn[k][j]; yq[k][j] = yn[k][j]; }
    }
#undef RW_ADDR
#undef RW_LOAD
#undef RW_ROW
#undef RW_SROW
}

__device__ __forceinline__ void phase_qkp(KP P, LAS unsigned char* lds, int G, const int tidx_, const int bidx_) {
    const int tid = tidx_, wid = tid >> 6, lane = tid & 63;
    bf16_t* U = (bf16_t*)(P->ws + BIG_U); bf16_t* MIX = (bf16_t*)(P->ws + BIG_MIX);
    LAS float* PW = (LAS float*)lds;
    for (int i = tid; i < 4 * 64 * 64; i += 512) PW[i] = P->in[I_POOLW][i];
    LAS float* ROPE = (LAS float*)(lds + 65536);
    for (int i = tid; i < 192 * 32; i += 512) { const int pidx = i >> 5, m = i & 31; const float pos = (float)(pidx < 128 ? pidx : pidx - 128);
        float sn, cs; sincosf(pos * powf(10000.f, -(float)m / 32.f), &sn, &cs); ROPE[2 * i] = cs; ROPE[2 * i + 1] = sn; }
    __syncthreads();
    const int head = lane >> 3, l8 = lane & 7;
    const float* gain = (head < 6 ? P->in[I_QG] : P->in[I_KG]) + l8 * 16;
    float gn[16];
#pragma unroll
    for (int e = 0; e < 16; ++e) gn[e] = gain[e];
    const bool use_row = l8 < 4;
    float psc[4];
#pragma unroll
    for (int g = 0; g < 4; ++g) psc[g] = P->in[I_POOLS][g * 64 + lane];
    const int gw = bidx_ * 8 + wid, NGW = G * 8;
    for (int r = gw; r < MR; r += NGW) {
        const int b = r / RPB, j = r - b * RPB; const bool isctx = j < CTXL;
        const int t = isctx ? j : j - CTXL, T = isctx ? CTXL : SEQ;
        bf16_t* urow = U + (size_t)r * INA;
        {
            const u32x4 q0 = *(const u32x4*)(urow + 256 + 16 * lane), q1 = *(const u32x4*)(urow + 256 + 16 * lane + 8);
            float v[16]; { float a[8], c[8]; unpack8(q0, a); unpack8(q1, c);
#pragma unroll
                for (int e = 0; e < 8; ++e) { v[e] = a[e]; v[8 + e] = c[e]; } }
            float ss = 0.f;
#pragma unroll
            for (int e = 0; e < 16; ++e) ss += v[e] * v[e];
            ss += shx(ss, 1, lane); ss += shx(ss, 2, lane); ss += shx(ss, 4, lane);
            const float rstd = rsqrtf(ss * (1.f / 128.f) + EPS);
#pragma unroll
            for (int e = 0; e < 16; ++e) v[e] = v[e] * rstd * gn[e];
            if (!isctx) {
                const int pidx = use_row ? (t >> 6) : 128 + (t & 63);
#pragma unroll
                for (int i = 0; i < 8; ++i) { const int m = (l8 & 3) * 8 + i; const float cs = ROPE[(pidx * 32 + m) * 2], sn = ROPE[(pidx * 32 + m) * 2 + 1];
                    const float x1 = v[2 * i], x2 = v[2 * i + 1]; v[2 * i] = x1 * cs - x2 * sn; v[2 * i + 1] = x1 * sn + x2 * cs; }
            }
            float a[8], c[8];
#pragma unroll
            for (int e = 0; e < 8; ++e) { a[e] = v[e]; c[e] = v[8 + e]; }
            *(u32x4*)(urow + 256 + 16 * lane) = pack8(a); *(u32x4*)(urow + 256 + 16 * lane + 8) = pack8(c);
        }
#pragma unroll
        for (int g = 0; g < 4; ++g) {
            const int w = 2 << g, left = w >> 1, right = w - 1 - left;
            const int lo = (t - left) > 0 ? (t - left) : 0, hi = (t + right) < (T - 1) ? (t + right) : (T - 1);
            float s = 0.f;
            for (int tt = lo; tt <= hi; ++tt) s += bflo((unsigned)urow[(long)(tt - t) * INA + g * 64 + lane]);
            const float self = bflo((unsigned)urow[g * 64 + lane]);
            const float part = s / (float)(hi - lo + 1) - self;
            float y = 0.f;
#pragma unroll 16
            for (int i = 0; i < 64; ++i) y += rdlane(part, i) * PW[(g * 64 + i) * 64 + lane];
            y *= psc[g];
            MIX[(size_t)r * DM + g * 64 + lane] = (bf16_t)(cvt_pk_bf16(y, 0.f) & 0xffffu);
        }
    }
}

__device__ __forceinline__ void attn_unit(KP P, char* lds, int b, int h, int qb, bool ctx, const int tidx_) {
    bf16_t* U = (bf16_t*)(P->ws + BIG_U); bf16_t* MIX = (bf16_t*)(P->ws + BIG_MIX);
    const int kvh = h / 3;
    const size_t R0 = (size_t)b * RPB, RQ = ctx ? R0 : R0 + CTXL + (size_t)qb * 256;
    att::attn_dense_body(U + RQ * INA + 256 + h * 128, U + R0 * INA + 1024 + kvh * 128, U + R0 * INA + 1280 + kvh * 128,
                         MIX + RQ * DM + 256 + h * 128, ctx ? CTXL : RPB, lds, tidx_);
    __syncthreads();
}
__device__ __forceinline__ void phase_attn(KP P, char* lds, int G, const int tidx_, const int bidx_) {
    const int bid = bidx_;
    const int nlat = (G == 256) ? 6 : (1536 - bid + G - 1) / G;
    const int nctx = (bid < 48) ? (48 - bid + G - 1) / G : 0;
    for (int i = 0; i < nlat + nctx; ++i) {
        int b, h, qb; bool ctx;
        if (i < nlat) {
            int grp, idx;
            if (G == 256) { const int xcd = bid & 7, cu = bid >> 3; grp = 2 * xcd + i / 3; idx = (i % 3) * 32 + cu; }
            else { const int u = bid + i * G; grp = u / 96; idx = u % 96; }
            b = grp >> 1; h = (grp & 1) * 3 + (idx >> 5); qb = idx & 31; ctx = false;
        } else { const int u = bid + (i - nlat) * G; b = u / 6; h = u % 6; qb = 0; ctx = true; }
        attn_unit(P, lds, b, h, qb, ctx, tidx_);
    }
}

__device__ __forceinline__ bool seq_first(int r0, int rspace) { if (rspace) { const int j = r0 % RPB; return j == 0 || j == CTXL; } return (r0 % SEQ) == 0; }
__device__ __forceinline__ bool seq_last(int r0, int rspace) { if (rspace) { const int j = (r0 + 64) % RPB; return j == 0 || j == CTXL; } return ((r0 + 64) % SEQ) == 0; }

__device__ __forceinline__ void phase_halo_f(KP P, int rows, int G, const int tidx_, const int bidx_) {
    const bf16_t* UP = (const bf16_t*)(P->ws + BIG_UP); bf16_t* HL = (bf16_t*)(P->ws + WS_HALO);
    const long total = (long)(rows / 64) * 2 * 704;
    for (long idx = (long)bidx_ * 512 + tidx_; idx < total; idx += (long)G * 512) {
        const int v = (int)(idx % 704); const long q = idx / 704; const int w = (int)(q & 1); const long rb = q >> 1;
        const long row = rb * 64 + (w ? 63 : 0);
        *(u32x4*)(HL + (size_t)q * DFF2 + 8 * v) = *(const u32x4*)(UP + (size_t)row * DFF2 + 8 * v);
    }
}
__device__ __forceinline__ void phase_cg(KP P, int rows, int rspace, int layer, int G, const int tidx_, const int bidx_) {
    bf16_t* UP = (bf16_t*)(P->ws + BIG_UP); const bf16_t* HL = (const bf16_t*)(P->ws + WS_HALO);
    const float* CW = P->in[I_FCW] + (size_t)layer * DFF2 * 3; const float* CB = P->in[I_FCB] + (size_t)layer * DFF2;
    const long total = (long)(rows / 64) * 352;
    const u32x4 Z4 = (u32x4){0u, 0u, 0u, 0u};
    for (long idx = (long)bidx_ * 512 + tidx_; idx < total; idx += (long)G * 512) {
        const int v = (int)(idx % 352); const int rb = (int)(idx / 352); const int r0 = rb * 64;
        const bool first = seq_first(r0, rspace), last = seq_last(r0, rspace);
        float wv[8][3], wg[8][3], bv[8], bg[8];
#pragma unroll
        for (int e = 0; e < 8; ++e) {
#pragma unroll
            for (int k = 0; k < 3; ++k) { wv[e][k] = CW[(8 * v + e) * 3 + k]; wg[e][k] = CW[(DFF + 8 * v + e) * 3 + k]; }
            bv[e] = CB[8 * v + e]; bg[e] = CB[DFF + 8 * v + e]; }
        u32x4 pv_ = first ? Z4 : *(const u32x4*)(HL + ((size_t)(rb - 1) * 2 + 1) * DFF2 + 8 * v);
        u32x4 pg_ = first ? Z4 : *(const u32x4*)(HL + ((size_t)(rb - 1) * 2 + 1) * DFF2 + DFF + 8 * v);
        bf16_t* base = UP + (size_t)r0 * DFF2 + 8 * v;
        u32x4 cv_ = *(const u32x4*)base, cg_ = *(const u32x4*)(base + DFF);
        u32x4 nv_ = *(const u32x4*)(base + (size_t)DFF2), ng_ = *(const u32x4*)(base + (size_t)DFF2 + DFF);
        const u32x4 hv_ = last ? Z4 : *(const u32x4*)(HL + ((size_t)(rb + 1) * 2) * DFF2 + 8 * v), hg_ = last ? Z4 : *(const u32x4*)(HL + ((size_t)(rb + 1) * 2) * DFF2 + DFF + 8 * v);
        for (int t = 0; t < 64; ++t) {
            u32x4 fv_ = hv_, fg_ = hg_;
            if (t + 2 < 64) { fv_ = *(const u32x4*)(base + (size_t)(t + 2) * DFF2); fg_ = *(const u32x4*)(base + (size_t)(t + 2) * DFF2 + DFF); }
            float a0[8], a1[8], a2[8], g0[8], g1[8], g2[8], o[8];
            unpack8(pv_, a0); unpack8(cv_, a1); unpack8(nv_, a2); unpack8(pg_, g0); unpack8(cg_, g1); unpack8(ng_, g2);
#pragma unroll
            for (int e = 0; e < 8; ++e) { const float val = bv[e] + wv[e][0] * a0[e] + wv[e][1] * a1[e] + wv[e][2] * a2[e];
                const float gt = bg[e] + wg[e][0] * g0[e] + wg[e][1] * g1[e] + wg[e][2] * g2[e]; o[e] = siluf(gt) * val; }
            *(u32x4*)(base + (size_t)t * DFF2) = pack8(o);
            pv_ = cv_; pg_ = cg_; cv_ = nv_; cg_ = ng_; nv_ = fv_; ng_ = fg_;
        }
    }
}
__device__ __forceinline__ void phase_halo_s(KP P, int G, const int tidx_, const int bidx_) {
    const bf16_t* XBC = (const bf16_t*)(P->ws + BIG_XBC); bf16_t* HL = (bf16_t*)(P->ws + WS_HALO);
    const long total = (long)(MR / 64) * 3 * 384;
    for (long idx = (long)bidx_ * 512 + tidx_; idx < total; idx += (long)G * 512) {
        const int v = (int)(idx % 384); const long q = idx / 384; const int w = (int)(q % 3); const long rb = q / 3;
        const long row = rb * 64 + (w == 0 ? 0 : 61 + w);
        *(u32x4*)(HL + (size_t)q * CONVD + 8 * v) = *(const u32x4*)(XBC + (size_t)row * CONVD + 8 * v);
    }
}
__device__ __forceinline__ void phase_conv_s(KP P, int G, const int tidx_, const int bidx_) {
    bf16_t* XBC = (bf16_t*)(P->ws + BIG_XBC); const bf16_t* HL = (const bf16_t*)(P->ws + WS_HALO);
    const float* CW = P->in[I_SCW]; const float* CB = P->in[I_SCB];
    const long total = (long)(MR / 64) * 384;
    const u32x4 Z4 = (u32x4){0u, 0u, 0u, 0u};
    for (long idx = (long)bidx_ * 512 + tidx_; idx < total; idx += (long)G * 512) {
        const int v = (int)(idx % 384); const int rb = (int)(idx / 384); const int r0 = rb * 64;
        const bool first = seq_first(r0, 1), last = seq_last(r0, 1);
        float w[8][4], bb[8];
#pragma unroll
        for (int e = 0; e < 8; ++e) { const f32x4 q = *(const f32x4*)(CW + (size_t)(8 * v + e) * 4); w[e][0] = q.x; w[e][1] = q.y; w[e][2] = q.z; w[e][3] = q.w; bb[e] = CB[8 * v + e]; }
        u32x4 pp = first ? Z4 : *(const u32x4*)(HL + ((size_t)(rb - 1) * 3 + 1) * CONVD + 8 * v);
        u32x4 p1 = first ? Z4 : *(const u32x4*)(HL + ((size_t)(rb - 1) * 3 + 2) * CONVD + 8 * v);
        bf16_t* base = XBC + (size_t)r0 * CONVD + 8 * v;
        u32x4 cu = *(const u32x4*)base, nx = *(const u32x4*)(base + (size_t)CONVD);
        const u32x4 hx = last ? Z4 : *(const u32x4*)(HL + ((size_t)(rb + 1) * 3) * CONVD + 8 * v);
        for (int t = 0; t < 64; ++t) {
            u32x4 fx = hx;
            if (t + 2 < 64) fx = *(const u32x4*)(base + (size_t)(t + 2) * CONVD);
            float a0[8], a1[8], a2[8], a3[8], o[8];
            unpack8(pp, a0); unpack8(p1, a1); unpack8(cu, a2); unpack8(nx, a3);
#pragma unroll
            for (int e = 0; e < 8; ++e) { const float a = bb[e] + w[e][0] * a0[e] + w[e][1] * a1[e] + w[e][2] * a2[e] + w[e][3] * a3[e]; o[e] = siluf(a); }
            *(u32x4*)(base + (size_t)t * CONVD) = pack8(o);
            pp = p1; p1 = cu; cu = nx; nx = fx;
        }
    }
}

__device__ __forceinline__ unsigned offb(unsigned R, unsigned ch) { return 256u * R + 16u * (ch ^ (((R & 3u) << 2) | ((R >> 2) & 3u))); }
__device__ __forceinline__ bf16x8 rowfrag(LAS const unsigned char* tile, int rb, int s, int lane) {
    return *(LAS const bf16x8*)(tile + offb(32 * rb + (lane & 31), 2 * s + (lane >> 5)));
}
__device__ __forceinline__ s16x4 trd(LAS const unsigned char* p) { return __builtin_bit_cast(s16x4, __builtin_amdgcn_ds_read_tr16_b64_v4i16((LAS v4i16_t*)p)); }
__device__ __forceinline__ bf16x8 trfrag(LAS const unsigned char* tile, int c, int ks, int lane) {
    const unsigned h = lane >> 5, blk = (lane >> 4) & 1, q = (lane & 15) >> 2, p = lane & 3;
    const unsigned ch = 4 * c + 2 * blk + (p >> 1), r0 = 16 * ks + 8 * h + q;
    const s16x4 lo = trd(tile + offb(r0, ch) + 8 * (p & 1)), hi = trd(tile + offb(r0 + 4, ch) + 8 * (p & 1));
    return (bf16x8){lo[0], lo[1], lo[2], lo[3], hi[0], hi[1], hi[2], hi[3]};
}

__device__ __forceinline__ void phase_ssd(KP P, LAS unsigned char* lds, int G, const int tidx_, const int bidx_) {
    const int tid = tidx_, wid = __builtin_amdgcn_readfirstlane(tid >> 6), lane = tid & 63, r32 = lane & 31, hi = lane >> 5;
    LAS unsigned char* BT = lds; LAS unsigned char* CT = lds + 32768; LAS unsigned char* X2 = lds + 65536; LAS unsigned char* HS = lds + 98304;
    LAS float* sarr = (LAS float*)(lds + 114688);
    LAS float* YST = (LAS float*)(lds + 118784);
    const bf16_t* XBC = (const bf16_t*)(P->ws + BIG_XBC); const float* DT = (const float*)(P->ws + BIG_DT); bf16_t* YS = (bf16_t*)(P->ws + BIG_YS);
    const int lb = (wid < 4) ? (wid >> 1) : (wid < 6 ? 3 : 2), pb = wid & 1;
    for (int u = bidx_; u < NB * 32; u += G) {
        const int b = (G == 256) ? (u & 7) : (u >> 5), h = (G == 256) ? (u >> 3) : (u & 31), g = h >> 3;
        const float Dk = P->in[I_SD][h];
        for (int dir = 0; dir < 2; ++dir) {
            const float A = -expf(P->in[I_SALOG][dir * 32 + h]);
            const int sgn = dir ? -1 : 1;
            f32x16 hacc = {};
            for (int i = tid; i < 1024; i += 512) *(LAS u32x4*)(HS + 16 * i) = (u32x4){0u, 0u, 0u, 0u};
            u32x4 pfB[4], pfC[4], pfX[2]; float pfd0 = 0.f, pfd1 = 0.f;
#define SSD_J0(c) ((c) < 2 ? (dir ? 255 - 128 * (c) : 128 * (c)) : (dir ? 8447 - 128 * ((c) - 2) : 256 + 128 * ((c) - 2)))
#define SSD_PREFETCH(c) do { const int j0_ = SSD_J0(c); const size_t rbase_ = (size_t)b * RPB; \
    _Pragma("unroll") for (int i = 0; i < 4; ++i) { const int v = tid + 512 * i, l = v >> 4, ch = v & 15; const bf16_t* rp = XBC + (rbase_ + j0_ + sgn * l) * CONVD; \
        pfB[i] = *(const u32x4*)(rp + 2048 + g * 128 + 8 * ch); pfC[i] = *(const u32x4*)(rp + 2560 + g * 128 + 8 * ch); } \
    _Pragma("unroll") for (int i = 0; i < 2; ++i) { const int v = tid + 512 * i, l = v >> 3, xc = v & 7; pfX[i] = *(const u32x4*)(XBC + (rbase_ + j0_ + sgn * l) * CONVD + h * 64 + 8 * xc); } \
    if (wid == 0) { pfd0 = DT[(rbase_ + j0_ + sgn * (2 * lane)) * 64 + dir * 32 + h]; pfd1 = DT[(rbase_ + j0_ + sgn * (2 * lane + 1)) * 64 + dir * 32 + h]; } } while (0)
#define SSD_SCAN(buf_) do { LAS float* ac_ = sarr + (buf_) * 512; const float a0 = pfd0 * A, a1 = pfd1 * A; float incl = a0 + a1; \
    _Pragma("unroll") for (int o = 1; o < 64; o <<= 1) { const float t = shup(incl, o, lane); if (lane >= o) incl += t; } \
    const float tot = rdlane(incl, 63); const float c0 = incl - a1; \
    ac_[2 * lane] = c0; ac_[2 * lane + 1] = incl; ac_[128 + 2 * lane] = __expf(c0); ac_[128 + 2 * lane + 1] = __expf(incl); \
    ac_[256 + 2 * lane] = pfd0; ac_[256 + 2 * lane + 1] = pfd1; ac_[384 + 2 * lane] = __expf(tot - c0); ac_[384 + 2 * lane + 1] = __expf(tot - incl); } while (0)
#define SSD_TILES(buf_) do { LAS float* dtv_ = sarr + (buf_) * 512 + 256; LAS float* wdec_ = dtv_ + 128; \
    _Pragma("unroll") for (int i = 0; i < 4; ++i) { const int v = tid + 512 * i, l = v >> 4, ch = v & 15; *(LAS u32x4*)(BT + offb(l, ch)) = pfB[i]; *(LAS u32x4*)(CT + offb(l, ch)) = pfC[i]; } \
    _Pragma("unroll") for (int i = 0; i < 2; ++i) { const int v = tid + 512 * i, l = v >> 3, xc = v & 7; float f[8], xd[8], xw[8]; unpack8(pfX[i], f); const float d = dtv_[l], w = wdec_[l]; \
        _Pragma("unroll") for (int e = 0; e < 8; ++e) { xd[e] = f[e] * d; xw[e] = xd[e] * w; } \
        *(LAS u32x4*)(X2 + offb(l, xc)) = pack8(xd); *(LAS u32x4*)(X2 + offb(l, 8 + xc)) = pack8(xw); } } while (0)
            SSD_PREFETCH(0);
            if (wid == 0) SSD_SCAN(0);
            __syncthreads();
            SSD_TILES(0);
            SSD_PREFETCH(1);
            __syncthreads();
            for (int c = 0; c < 66; ++c) {
                const int j0 = SSD_J0(c);
                const bool outp = c >= 2;
                LAS float* acum = sarr + (c & 1) * 512; LAS float* eac = acum + 128;
                if (wid == 0 && c + 1 < 66) SSD_SCAN((c + 1) & 1);
                f32x16 yacc = {}, sacc = {};
                if (outp) {
                    const float al = acum[32 * lb + r32];
                    for (int sb = 0; sb <= lb; ++sb) {
                        f32x16 accT = {};
#pragma unroll
                        for (int s = 0; s < 8; ++s) accT = __builtin_amdgcn_mfma_f32_32x32x16_bf16(rowfrag(BT, sb, s, lane), rowfrag(CT, lb, s, lane), accT, 0, 0, 0);
                        float val[16];
#pragma unroll
                        for (int qd = 0; qd < 4; ++qd) { const f32x4 as = *(LAS const f32x4*)(acum + 32 * sb + 8 * qd + 4 * hi);
#pragma unroll
                            for (int e = 0; e < 4; ++e) { const int sidx = 32 * sb + 8 * qd + 4 * hi + e, lidx = 32 * lb + r32; val[4 * qd + e] = (sidx <= lidx) ? accT[4 * qd + e] * __expf(al - as[e]) : 0.f; } }
                        bf16x8 ma0, ma1; PK4(val, 0, ma0); PK4(val, 8, ma1);
                        yacc = __builtin_amdgcn_mfma_f32_32x32x16_bf16(ma0, trfrag(X2, pb, 2 * sb, lane), yacc, 0, 0, 0);
                        yacc = __builtin_amdgcn_mfma_f32_32x32x16_bf16(ma1, trfrag(X2, pb, 2 * sb + 1, lane), yacc, 0, 0, 0);
                    }
#pragma unroll
                    for (int g4 = 0; g4 < 2; ++g4) {
                        bf16x8 cfr[4], hfr[4];
#pragma unroll
                        for (int s = 0; s < 4; ++s) { cfr[s] = rowfrag(CT, lb, 4 * g4 + s, lane); hfr[s] = rowfrag(HS, pb, 4 * g4 + s, lane); }
#pragma unroll
                        for (int s = 0; s < 4; ++s) sacc = __builtin_amdgcn_mfma_f32_32x32x16_bf16(cfr[s], hfr[s], sacc, 0, 0, 0);
                    }
                }
                {
                    const float etot = eac[127];
#pragma unroll
                    for (int r = 0; r < 16; ++r) hacc[r] *= etot;
#pragma unroll
                    for (int g4 = 0; g4 < 2; ++g4) {
                        bf16x8 af[4], xw[4];
#pragma unroll
                        for (int ks = 0; ks < 4; ++ks) { af[ks] = trfrag(BT, lb, 4 * g4 + ks, lane); xw[ks] = trfrag(X2, 2 + pb, 4 * g4 + ks, lane); }
#pragma unroll
                        for (int ks = 0; ks < 4; ++ks) hacc = __builtin_amdgcn_mfma_f32_32x32x16_bf16(af[ks], xw[ks], hacc, 0, 0, 0);
                    }
                }
                __syncthreads();
#pragma unroll
                for (int qd = 0; qd < 4; ++qd) { u32x2 w; w.x = cvt_pk_bf16(hacc[4 * qd], hacc[4 * qd + 1]); w.y = cvt_pk_bf16(hacc[4 * qd + 2], hacc[4 * qd + 3]);
                    *(LAS u32x2*)(HS + offb(32 * pb + r32, 4 * lb + qd) + 8 * hi) = w; }
                if (outp) {
#pragma unroll
                    for (int qd = 0; qd < 4; ++qd) { const f32x4 ea = *(LAS const f32x4*)(eac + 32 * lb + 8 * qd + 4 * hi);
#pragma unroll
                        for (int e = 0; e < 4; ++e) YST[(32 * lb + 8 * qd + 4 * hi + e) * 64 + 32 * pb + r32] = yacc[4 * qd + e] + ea[e] * sacc[4 * qd + e]; }
                }
                if (c + 1 < 66) SSD_TILES((c + 1) & 1);
                __syncthreads();
                if (c + 2 < 66) SSD_PREFETCH(c + 2);
                if (outp) {
#pragma unroll
                    for (int i = 0; i < 2; ++i) { const int v = tid + 512 * i, l = v >> 3, pv8 = v & 7;
                        const f32x4 y0 = *(LAS const f32x4*)(YST + l * 64 + 8 * pv8), y1 = *(LAS const f32x4*)(YST + l * 64 + 8 * pv8 + 4);
                        float y[8] = {y0.x, y0.y, y0.z, y0.w, y1.x, y1.y, y1.z, y1.w};
                        const int jrow = j0 + sgn * l;
                        bf16_t* yp = YS + ((size_t)b * SEQ + (jrow - CTXL)) * DIN + h * 64 + 8 * pv8;
                        if (dir) { float yf[8], xs[8]; unpack8(*(const u32x4*)yp, yf); unpack8(*(const u32x4*)(XBC + ((size_t)b * RPB + jrow) * CONVD + h * 64 + 8 * pv8), xs);
#pragma unroll
                            for (int e = 0; e < 8; ++e) y[e] += yf[e] + Dk * xs[e]; }
                        *(u32x4*)yp = pack8(y); }
                }
            }
            __syncthreads();
#undef SSD_J0
#undef SSD_PREFETCH
#undef SSD_SCAN
#undef SSD_TILES
        }
    }
}

constexpr int PH_KIND0[24] = {0, 1, 2, 3, 4, 2, 1, 2, 2, 1, 2, 9, 2, 2, 1, 2, 2, 1, 99, 99, 99, 99, 99, 99};
constexpr int PH_ARG0[24]  = {0, 0, 0, 0, 0, 1, 1, 2, 3, 2, 4, 0, 5, 6, 3, 7, 8, 4, 0, 0, 0, 0, 0, 0};
#ifndef DUP_PH
#define DUP_PH -1
#endif
constexpr int ph_src(int i) { return (DUP_PH >= 0 && i > DUP_PH) ? i - 1 : i; }
#define NPH_RUN (18 + (DUP_PH >= 0 ? 1 : 0))
#ifndef PHMASK
#define PHMASK 0x3ff
#endif
#define EN(k) (((PHMASK) >> (k)) & 1)

template <int PH>
__device__ __forceinline__ void run_phase(cg::grid_group& grid, unsigned char* smem, const int wave_s) {
    if constexpr (PH < NPH_RUN) {
    constexpr int kind = PH_KIND0[ph_src(PH)], arg = PH_ARG0[ph_src(PH)];
    LAS unsigned char* lds = (LAS unsigned char*)smem;
    KP P = (KP)__builtin_amdgcn_kernarg_segment_ptr();
    asm volatile("" : "+s"(P));
    int G = gridDim.x; asm volatile("" : "+s"(G));
    int tidx_; asm volatile("v_mbcnt_lo_u32_b32 %0, -1, 0\n\tv_mbcnt_hi_u32_b32 %0, -1, %0" : "=v"(tidx_)); tidx_ += wave_s * 64;
    int bidx_ = __builtin_amdgcn_workgroup_id_x(); asm volatile("" : "+s"(bidx_));
    unsigned char* ws = P->ws;
    const float* NW = P->in[I_NORMW];
    bf16_t* YX = (bf16_t*)(ws + WS_YX);
    if constexpr (kind == 2 && EN(2)) {
        pg8::Gemm g; pg8::EpiMulti E; E.mode = 0; E.dt = nullptr; E.dtb = nullptr; E.rowss = (float*)(ws + WS_ROWSS); g.amap = 0; g.cmode = 0; E.halo = (bf16_t*)(ws + WS_HALO); E.halomode = 0; E.cw = nullptr; E.cbias = nullptr; E.rspace = 1; E.Mrows = 0;
        if constexpr (arg == 0) { g.A = YX; g.lda = 1024; g.Bt = (const bf16_t*)(ws + W_AIN); g.M = MR; g.N = INA; g.K = 1024; E.O = (bf16_t*)(ws + BIG_U); E.ldc = INA; }
        else if constexpr (arg == 1) { g.A = (const bf16_t*)(ws + BIG_MIX); g.lda = 1024; g.Bt = (const bf16_t*)(ws + W_AOUT); g.M = MR; g.N = 1024; g.K = 1024; E.O = YX; E.ldc = 1024; }
        else if constexpr (arg == 2) { g.A = YX; g.lda = 1024; g.Bt = (const bf16_t*)(ws + W_UP0); g.M = MR; g.N = DFF2; g.K = 1024; g.cmode = 1; E.mode = 4; E.O = (bf16_t*)(ws + BIG_H); E.ldc = DFF; E.cw = P->in[I_FCW]; E.cbias = P->in[I_FCB]; E.rspace = 1; E.Mrows = MR; }
        else if constexpr (arg == 3) { g.A = (const bf16_t*)(ws + BIG_H); g.lda = DFF; g.Bt = (const bf16_t*)(ws + W_DN0); g.M = MR; g.N = 1024; g.K = DFF; E.O = YX; E.ldc = 1024; }
        else if constexpr (arg == 4) { g.A = YX; g.lda = 1024; g.Bt = (const bf16_t*)(ws + W_SIN) + (size_t)DIN * 1024; g.M = MR; g.N = NXD; g.K = 1024; g.cmode = 2; E.mode = 5; E.O = (bf16_t*)(ws + BIG_XBC); E.ldc = CONVD;
                E.dt = (float*)(ws + BIG_DT); E.dtb = P->in[I_SDTB]; E.cw = P->in[I_SCW]; E.cbias = P->in[I_SCB]; E.rspace = 1; E.Mrows = MR; }
        else if constexpr (arg == 5) { g.A = YX; g.lda = 1024; g.amap = 1; g.Bt = (const bf16_t*)(ws + W_SIN); g.M = MT; g.N = DIN; g.K = 1024; E.mode = 2; E.O = (bf16_t*)(ws + BIG_YS); E.ldc = DIN; }
        else if constexpr (arg == 6) { g.A = (const bf16_t*)(ws + BIG_YS); g.lda = DIN; g.Bt = (const bf16_t*)(ws + W_SOUT); g.M = MT; g.N = 1024; g.K = DIN; E.mode = 3; E.O = (bf16_t*)(ws + BIG_YOUT); E.ldc = 1024; }
        else if constexpr (arg == 7) { g.A = YX; g.lda = 1024; g.Bt = (const bf16_t*)(ws + W_UP1); g.M = MT; g.N = DFF2; g.K = 1024; g.cmode = 1; E.mode = 4; E.O = (bf16_t*)(ws + BIG_H); E.ldc = DFF; E.cw = P->in[I_FCW] + (size_t)DFF2 * 3; E.cbias = P->in[I_FCB] + DFF2; E.rspace = 0; E.Mrows = MT; }
        else { g.A = (const bf16_t*)(ws + BIG_H); g.lda = DFF; g.Bt = (const bf16_t*)(ws + W_DN1); g.M = MT; g.N = 1024; g.K = DFF; E.O = YX; E.ldc = 1024; }
        pg8::StaticOrder S; S.init(g.cmode == 1 ? (g.M + 247) / 248 : g.cmode == 2 ? (g.M + 249) / 250 : g.M / pg8::BM, g.N, G, bidx_);
        pg8::gemm_phase<pg8::EpiMulti, pg8::StaticOrder>(lds, g, S, E, tidx_);
    } else if constexpr (kind == 1 && EN(1)) {
        RwDesc d; d.srcL = nullptr; d.srcC = nullptr; d.xsrc = nullptr; d.xdst = nullptr; d.odst = nullptr; d.Y = nullptr; d.nwA = nullptr; d.gate_k = 0; d.nwB = nullptr; d.shift_k = 0; d.scale_k = 0; d.XN = YX;
        bf16_t* XRES = (bf16_t*)(ws + WS_XRES);
        if constexpr (arg == 0) { d.rows = MR; d.rspace = 1; d.layer = 0; d.layerB = 0; d.srcL = P->in[I_X]; d.srcC = P->in[I_CTX]; d.nwB = NW + 0 * 1024; d.shift_k = 0; d.scale_k = 1; }
        else if constexpr (arg == 1) { d.rows = MR; d.rspace = 1; d.layer = 0; d.layerB = 0; d.srcL = P->in[I_X]; d.srcC = P->in[I_CTX]; d.xdst = XRES; d.Y = YX; d.nwA = NW + 1 * 1024; d.gate_k = 2; d.nwB = NW + 2 * 1024; d.shift_k = 3; d.scale_k = 4; }
        else if constexpr (arg == 2) { d.rows = MR; d.rspace = 1; d.layer = 0; d.layerB = 1; d.xsrc = XRES; d.xdst = XRES; d.Y = YX; d.nwA = NW + 3 * 1024; d.gate_k = 5; d.nwB = NW + 4 * 1024; d.shift_k = 0; d.scale_k = 1; }
        else if constexpr (arg == 3) { d.rows = MT; d.rspace = 0; d.layer = 1; d.layerB = 1; d.xsrc = XRES; d.xdst = XRES; d.Y = (const bf16_t*)(ws + BIG_YOUT); d.nwA = NW + 5 * 1024; d.gate_k = 2; d.nwB = NW + 6 * 1024; d.shift_k = 3; d.scale_k = 4; }
        else { d.rows = MT; d.rspace = 0; d.layer = 1; d.layerB = 1; d.xsrc = XRES; d.odst = P->out; d.Y = YX; d.nwA = NW + 7 * 1024; d.gate_k = 5; d.XN = nullptr; }
        phase_rw(P, d, G, tidx_, bidx_);
    } else if constexpr (kind == 0 && EN(0)) phase_p0(P, lds, G, tidx_, bidx_);
    else if constexpr (kind == 3 && EN(3)) phase_qkp(P, lds, G, tidx_, bidx_);
    else if constexpr (kind == 4 && EN(4)) phase_attn(P, (char*)smem, G, tidx_, bidx_);
    else if constexpr (kind == 5 && EN(5)) phase_halo_f(P, arg ? MT : MR, G, tidx_, bidx_);
    else if constexpr (kind == 6 && EN(6)) phase_cg(P, arg ? MT : MR, arg ? 0 : 1, arg, G, tidx_, bidx_);
    else if constexpr (kind == 7 && EN(7)) phase_halo_s(P, G, tidx_, bidx_);
    else if constexpr (kind == 8 && EN(8)) phase_conv_s(P, G, tidx_, bidx_);
    else if constexpr (kind == 9 && EN(9)) phase_ssd(P, lds, G, tidx_, bidx_);
    asm volatile("s_waitcnt vmcnt(0)" ::: "memory");
    __syncthreads();
    if constexpr (PH == 0) {
        if (tidx_ == 0) {
            unsigned* bar = (unsigned*)(ws + WS_BAR);
            const unsigned xcc = (unsigned)__builtin_amdgcn_s_getreg((3 << 11) | 20) & 0xFu;
            __hip_atomic_fetch_add(bar + 16 * (1 + xcc), 1u, __ATOMIC_RELAXED, __HIP_MEMORY_SCOPE_AGENT);
            __builtin_amdgcn_fence(__ATOMIC_RELEASE, "agent"); asm volatile("s_waitcnt vmcnt(0)" ::: "memory");
        }
        grid.sync();
        if (tidx_ == 0) { __builtin_amdgcn_fence(__ATOMIC_ACQUIRE, "agent"); asm volatile("s_waitcnt vmcnt(0)" ::: "memory"); }
    } else {
        if (tidx_ == 0) {
            unsigned* bar = (unsigned*)(ws + WS_BAR);
            const unsigned xcc = (unsigned)__builtin_amdgcn_s_getreg((3 << 11) | 20) & 0xFu;
            const unsigned nloc = __hip_atomic_load(bar + 16 * (1 + xcc), __ATOMIC_RELAXED, __HIP_MEMORY_SCOPE_AGENT);
            unsigned nx = 0;
#pragma unroll
            for (int j = 0; j < 16; ++j) nx += __hip_atomic_load(bar + 16 * (1 + j), __ATOMIC_RELAXED, __HIP_MEMORY_SCOPE_AGENT) ? 1u : 0u;
            const unsigned old = __hip_atomic_fetch_add(bar + 16 * (17 + xcc), 1u, __ATOMIC_RELAXED, __HIP_MEMORY_SCOPE_AGENT);
            if (old + 1u == (unsigned)PH * nloc) {
                __builtin_amdgcn_fence(__ATOMIC_RELEASE, "agent"); asm volatile("s_waitcnt vmcnt(0)" ::: "memory");
                __hip_atomic_fetch_add(bar, 1u, __ATOMIC_RELAXED, __HIP_MEMORY_SCOPE_AGENT);
                const unsigned want = (unsigned)PH * nx;
                while (__hip_atomic_load(bar, __ATOMIC_RELAXED, __HIP_MEMORY_SCOPE_AGENT) < want) __builtin_amdgcn_s_sleep(1);
                __hip_atomic_fetch_add(bar + 16 * (33 + xcc), 1u, __ATOMIC_RELAXED, __HIP_MEMORY_SCOPE_AGENT);
            } else {
                while (__hip_atomic_load(bar + 16 * (33 + xcc), __ATOMIC_RELAXED, __HIP_MEMORY_SCOPE_AGENT) < (unsigned)PH) __builtin_amdgcn_s_sleep(1);
            }
            __builtin_amdgcn_fence(__ATOMIC_ACQUIRE, "agent"); asm volatile("s_waitcnt vmcnt(0)" ::: "memory");
        }
    }
    __syncthreads();
    }
}

__global__ void __launch_bounds__(512) mega(Params Pk) {
    extern __shared__ __attribute__((aligned(16))) unsigned char smem[];
    cg::grid_group grid = cg::this_grid();
    const int wave_s = __builtin_amdgcn_readfirstlane((int)__builtin_amdgcn_workitem_id_x() >> 6);
    run_phase<0>(grid, smem, wave_s);  run_phase<1>(grid, smem, wave_s);  run_phase<2>(grid, smem, wave_s);  run_phase<3>(grid, smem, wave_s);
    run_phase<4>(grid, smem, wave_s);  run_phase<5>(grid, smem, wave_s);  run_phase<6>(grid, smem, wave_s);  run_phase<7>(grid, smem, wave_s);
    run_phase<8>(grid, smem, wave_s);  run_phase<9>(grid, smem, wave_s);  run_phase<10>(grid, smem, wave_s); run_phase<11>(grid, smem, wave_s);
    run_phase<12>(grid, smem, wave_s); run_phase<13>(grid, smem, wave_s); run_phase<14>(grid, smem, wave_s); run_phase<15>(grid, smem, wave_s);
    run_phase<16>(grid, smem, wave_s); run_phase<17>(grid, smem, wave_s); run_phase<18>(grid, smem, wave_s); run_phase<19>(grid, smem, wave_s);
    run_phase<20>(grid, smem, wave_s); run_phase<21>(grid, smem, wave_s); run_phase<22>(grid, smem, wave_s); run_phase<23>(grid, smem, wave_s);
}

extern "C" void kernel_launch(void* const* d_in, const int* in_sizes, int n_in, void* d_out, int out_size, void* d_ws, size_t ws_size, hipStream_t stream) {
    static int grid_blocks = 0;
    if (grid_blocks == 0) {
        if (n_in != 25 || ws_size < WS_END) { fprintf(stderr, "kernel_launch: unexpected n_in %d or ws_size %zu (need %zu)\n", n_in, ws_size, (size_t)WS_END); grid_blocks = -1; return; }
        int dev = 0, cus = 0, per_cu = 0;
        hipGetDevice(&dev);
        hipDeviceGetAttribute(&cus, hipDeviceAttributeMultiprocessorCount, dev);
        if (hipFuncSetAttribute((const void*)mega, hipFuncAttributeMaxDynamicSharedMemorySize, LDS_BYTES) != hipSuccess) { fprintf(stderr, "kernel_launch: hipFuncSetAttribute failed\n"); grid_blocks = -1; return; }
        hipOccupancyMaxActiveBlocksPerMultiprocessor(&per_cu, (const void*)mega, 512, LDS_BYTES);
        if (per_cu < 1) { fprintf(stderr, "kernel_launch: occupancy query says %d blocks per CU\n", per_cu); per_cu = 1; }
        (void)hipGetLastError();
        grid_blocks = cus;
    }
    if (grid_blocks < 0) return;
    (void)hipMemsetAsync((char*)d_ws + WS_BAR, 0, 4096, stream);
    Params p{};
    for (int i = 0; i < 25; ++i) p.in[i] = (const float*)d_in[i];
    p.out = (float*)d_out; p.ws = (unsigned char*)d_ws;
    void* args[] = {&p};
    hipError_t e = hipLaunchCooperativeKernel((const void*)mega, dim3(grid_blocks), dim3(512), args, LDS_BYTES, stream);
    if (e != hipSuccess) fprintf(stderr, "cooperative launch failed: %s (grid %d)\n", hipGetErrorString(e), grid_blocks);
}
```

```cpp
#include <hip/hip_runtime.h>
#include <hip/hip_bf16.h>
#include <hip/hip_cooperative_groups.h>
#include <cstdio>
#include <cstdint>
namespace cg = cooperative_groups;

#define LAS __attribute__((address_space(3)))
typedef unsigned short bf16_t;
typedef short bf16x8 __attribute__((ext_vector_type(8)));
typedef short s16x4 __attribute__((ext_vector_type(4)));
typedef short v4i16_t __attribute__((ext_vector_type(4)));
typedef float f32x4 __attribute__((ext_vector_type(4)));
typedef float f32x16 __attribute__((ext_vector_type(16)));
typedef unsigned u32x4 __attribute__((ext_vector_type(4)));
typedef unsigned u32x2 __attribute__((ext_vector_type(2)));

constexpr int DM = 1024, NB = 8, SEQ = 8192, CTXL = 256, RPB = SEQ + CTXL, MR = NB * RPB, MT = NB * SEQ;
constexpr int INA = 1536, DFF = 2816, DFF2 = 5632, DIN = 2048, CONVD = 3072, NXD = 3328, SINP = 5376, INC = 5184;
constexpr float EPS = 1e-6f;
constexpr int LDS_BYTES = 152576;

constexpr size_t MiB = 1u << 20;
constexpr size_t WS_MOD = 0;
constexpr size_t WS_ROWSS = 512 * 1024;
constexpr size_t WS_BAR = 1024 * 1024 - 4096;
constexpr size_t WS_WB = 1 * MiB;
constexpr size_t W_AIN = WS_WB, W_AOUT = WS_WB + 3 * MiB, W_UP0 = WS_WB + 5 * MiB, W_DN0 = WS_WB + 16 * MiB;
constexpr size_t W_SIN = WS_WB + 22 * MiB, W_SOUT = WS_WB + 33 * MiB, W_UP1 = WS_WB + 37 * MiB, W_DN1 = WS_WB + 48 * MiB;
constexpr size_t WS_CX = 56 * MiB;
constexpr size_t WS_YX = 64 * MiB;
constexpr size_t WS_HALO = 196 * MiB;
constexpr size_t WS_BIG = 220 * MiB;
constexpr size_t WS_XRES = WS_BIG + 672 * MiB;
constexpr size_t WS_END = WS_XRES + 132 * MiB;
constexpr size_t BIG_U = WS_BIG, BIG_MIX = WS_BIG + 198 * MiB, BIG_UP = WS_BIG, BIG_H = WS_BIG;
constexpr size_t BIG_XBC = WS_BIG, BIG_DT = WS_BIG + 396 * MiB, BIG_YS = WS_BIG + 416 * MiB, BIG_YOUT = WS_BIG;

struct Params { const float* in[25]; float* out; unsigned char* ws; };
typedef const Params __attribute__((address_space(4)))* KP;
enum { I_X = 0, I_C, I_CTX, I_CCTX, I_ADAW, I_ADAB, I_NORMW, I_AWIN, I_POOLW, I_POOLS, I_QG, I_KG, I_AWOUT, I_SWIN, I_SCW, I_SCB, I_SALOG, I_SDTB, I_SD, I_SNW, I_SWOUT, I_FUP, I_FCW, I_FCB, I_FDN };

typedef float f32x2_t __attribute__((ext_vector_type(2))); typedef __bf16 bf16x2_t __attribute__((ext_vector_type(2)));
__device__ __forceinline__ unsigned cvt_pk_bf16(float lo, float hi) { f32x2_t v = {lo, hi}; bf16x2_t b = __builtin_convertvector(v, bf16x2_t); return __builtin_bit_cast(unsigned, b); }
__device__ __forceinline__ float bflo(unsigned w) { return __uint_as_float(w << 16); }
__device__ __forceinline__ float bfhi(unsigned w) { return __uint_as_float(w & 0xffff0000u); }
__device__ __forceinline__ void unpack8(const u32x4 q, float (&f)[8]) {
    f[0] = bflo(q.x); f[1] = bfhi(q.x); f[2] = bflo(q.y); f[3] = bfhi(q.y); f[4] = bflo(q.z); f[5] = bfhi(q.z); f[6] = bflo(q.w); f[7] = bfhi(q.w);
}
__device__ __forceinline__ u32x4 pack8(const float (&f)[8]) {
    u32x4 q; q.x = cvt_pk_bf16(f[0], f[1]); q.y = cvt_pk_bf16(f[2], f[3]); q.z = cvt_pk_bf16(f[4], f[5]); q.w = cvt_pk_bf16(f[6], f[7]); return q;
}
__device__ __forceinline__ float shx(float v, int mask, int lane) { return __int_as_float(__builtin_amdgcn_ds_bpermute(((lane ^ mask) & 63) << 2, __float_as_int(v))); }
__device__ __forceinline__ float shup(float v, int o, int lane) { return __int_as_float(__builtin_amdgcn_ds_bpermute(((lane - o) & 63) << 2, __float_as_int(v))); }
__device__ __forceinline__ float rdlane(float v, int i) { return __int_as_float(__builtin_amdgcn_readlane(__float_as_int(v), i)); }
__device__ __forceinline__ float wave_sum(float v, int lane) {
#pragma unroll
    for (int o = 1; o < 64; o <<= 1) v += shx(v, o, lane);
    return v;
}
__device__ __forceinline__ float siluf(float v) { return v * __builtin_amdgcn_rcpf(1.f + __expf(-v)); }

namespace pg8 {
constexpr int BM = 256, BK = 64, HALF = 128, HTB = HALF * BK * 2, STAGE_BYTES = 8 * HTB, NXCD = 8, WGM = 8;
__host__ __device__ __forceinline__ int lds_byte(int r, int c) { const int st = (r >> 4) * 2 + (c >> 5), rr = r & 15, cc = c & 31, ob = rr * 64 + cc * 2; return st * 1024 + (ob ^ (((ob >> 9) & 1) << 5)); }
__host__ __device__ __forceinline__ void stage_rc(int b, int& R, int& C) { const int st = b / 1024, sb = b % 1024, swz = sb ^ (((sb >> 9) & 1) << 5); R = (st >> 1) * 16 + swz / 64; C = (st & 1) * 32 + (swz % 64) / 2; }
__host__ __device__ __forceinline__ int perm32(int rho) { const int n = rho >> 4, i = rho & 15; return 8 * (i >> 2) + 4 * n + (i & 3); }

struct Unit { int pm, pn; };
struct Gemm { const bf16_t* A; const bf16_t* Bt; int M, N, K, lda, amap, cmode; };
__device__ __forceinline__ int tile_a(const Gemm& g, int pm) { return g.amap ? pm + (pm >> 5) + 1 : pm; }

struct StaticOrder {
    int nM, nN, nwg, G, c;
    __device__ void init(int nM_, int N, int G_, int c_) { nM = nM_; nN = N / BM; nwg = nM * nN; G = G_; c = c_; }
    __device__ bool next(int i, Unit& u) const {
        const long L = (long)i * G + c; if (L >= nwg) return false;
        int wgid = (int)L; { const int q = nwg / NXCD, r = nwg % NXCD, xcd = wgid % NXCD, off = wgid / NXCD; wgid = (xcd < r ? xcd * (q + 1) : r * (q + 1) + (xcd - r) * q) + off; }
        const int nig = WGM * nN, gid = wgid / nig, fm = gid * WGM, gsz = (nM - fm) < WGM ? (nM - fm) : WGM;
        u.pm = fm + ((wgid % nig) % gsz); u.pn = (wgid % nig) / gsz; return true;
    }
};

struct EpiMulti {
    static constexpr bool PERM = true;
    int mode;
    bf16_t* O; int ldc; float* dt; const float* dtb; float* rowss; bf16_t* halo; int halomode; const float* cw; const float* cbias; int rspace, Mrows;
    __device__ __forceinline__ void row_op(f32x4 a00, f32x4 a01, f32x4 a10, f32x4 a11, const int r, const int col0, const int pn, const int fq) const {
        float ss = 0.f, rs = 1.f;
        if (mode == 3) rs = rsqrtf(rowss[r] * (1.f / 2048.f) + EPS);
#pragma unroll
        for (int bj = 0; bj < 2; ++bj) {
            f32x4 v0 = bj ? a10 : a00, v1 = bj ? a11 : a01;
            const int c = col0 + bj * HALF;
            if (mode == 1 && pn == 12) {
                const int cc = c - CONVD;
                if (cc < 64) {
                    const f32x4 b0 = *(const f32x4*)(dtb + cc), b1 = *(const f32x4*)(dtb + cc + 4);
                    f32x4 o0, o1;
#pragma unroll
                    for (int e = 0; e < 4; ++e) { const float a = v0[e] + b0[e], b = v1[e] + b1[e]; o0[e] = a > 20.f ? a : __logf(1.f + __expf(a)); o1[e] = b > 20.f ? b : __logf(1.f + __expf(b)); }
                    *(f32x4*)(dt + (size_t)r * 64 + cc) = o0; *(f32x4*)(dt + (size_t)r * 64 + cc + 4) = o1;
                }
            } else {
                bf16_t* op = O + (size_t)r * ldc + c;
                if (mode == 2) {
                    const u32x4 yq = *(const u32x4*)op; float y[8]; unpack8(yq, y);
#pragma unroll
                    for (int e = 0; e < 4; ++e) { v0[e] = y[e] * siluf(v0[e]); v1[e] = y[4 + e] * siluf(v1[e]); ss += v0[e] * v0[e] + v1[e] * v1[e]; }
                }
                if (mode == 3) { v0 = v0 * rs; v1 = v1 * rs; }
                u32x4 w; w.x = cvt_pk_bf16(v0[0], v0[1]); w.y = cvt_pk_bf16(v0[2], v0[3]); w.z = cvt_pk_bf16(v1[0], v1[1]); w.w = cvt_pk_bf16(v1[2], v1[3]);
                *(u32x4*)op = w;
                if (halomode) {
                    const int r64 = r & 63;
                    if (halomode == 1) { if (r64 == 0 || r64 == 63) *(u32x4*)(halo + ((size_t)(r >> 6) * 2 + (r64 ? 1 : 0)) * ldc + c) = w; }
                    else { if (r64 == 0 || r64 >= 62) *(u32x4*)(halo + ((size_t)(r >> 6) * 3 + (r64 ? r64 - 61 : 0)) * ldc + c) = w; }
                }
            }
        }
        if (mode == 2) { const int ln = (r & 15) | (fq << 4); ss += shx(ss, 16, ln); ss += shx(ss, 32, ln); if (fq == 0) atomicAdd(rowss + r, ss); }
    }
    __device__ __forceinline__ void conv_epi(const f32x4 (&acc)[2][2][4][2], const Unit& u, int wr, int wc, int fr, int fq) const {
        const int lane = fr | (fq << 4);
        const int tokb = 248 * u.pm - 1 + 62 * wr + 4 * fr;
        const int colh = 128 * u.pn + 32 * wc + 8 * fq;
        unsigned fvalid = 0u, fstart = 0u, fend = 0u;
#pragma unroll
        for (int q = 0; q < 8; ++q) { const int m = q & 3, tok = tokb + 124 * (q >> 2) + m;
            const bool valid = !(fr == 0 && m == 0) && !(fr == 15 && m == 3) && tok >= 0 && tok < Mrows;
            bool sstart, send;
            if (rspace) { const int j = tok % RPB; sstart = (j == 0) || (j == CTXL); send = (j == CTXL - 1) || (j == RPB - 1); }
            else { const int j = tok & (SEQ - 1); sstart = (j == 0); send = (j == SEQ - 1); }
            fvalid |= (valid ? 1u : 0u) << q; fstart |= (sstart ? 1u : 0u) << q; fend |= (send ? 1u : 0u) << q; }
#pragma unroll
        for (int n = 0; n < 2; ++n) {
            float wv[4][3], wg[4][3], bv[4], bg[4];
#pragma unroll
            for (int e = 0; e < 4; ++e) { const int c = colh + 4 * n + e;
#pragma unroll
                for (int k = 0; k < 3; ++k) { wv[e][k] = cw[c * 3 + k]; wg[e][k] = cw[(DFF + c) * 3 + k]; }
                bv[e] = cbias[c]; bg[e] = cbias[DFF + c]; }
#pragma unroll
            for (int ai = 0; ai < 2; ++ai) {
                f32x4 pv, pg, nv, ng;
#pragma unroll
                for (int e = 0; e < 4; ++e) { pv[e] = shx(acc[ai][0][3][n][e], 0, lane - 1); pg[e] = shx(acc[ai][1][3][n][e], 0, lane - 1);
                    nv[e] = shx(acc[ai][0][0][n][e], 0, lane + 1); ng[e] = shx(acc[ai][1][0][n][e], 0, lane + 1); }
#pragma unroll
                for (int m = 0; m < 4; ++m) {
                    const int q = 4 * ai + m, tok = tokb + 124 * ai + m;
                    const bool valid = (fvalid >> q) & 1u, sstart = (fstart >> q) & 1u, send = (fend >> q) & 1u;
                    const f32x4 uv = acc[ai][0][m][n], ug = acc[ai][1][m][n];
                    const f32x4 qv = (m == 0) ? pv : acc[ai][0][m > 0 ? m - 1 : 0][n], qg = (m == 0) ? pg : acc[ai][1][m > 0 ? m - 1 : 0][n];
                    const f32x4 rv = (m == 3) ? nv : acc[ai][0][m < 3 ? m + 1 : 3][n], rg = (m == 3) ? ng : acc[ai][1][m < 3 ? m + 1 : 3][n];
                    float h[4];
#pragma unroll
                    for (int e = 0; e < 4; ++e) {
                        float val = bv[e] + wv[e][1] * uv[e], gt = bg[e] + wg[e][1] * ug[e];
                        val += sstart ? 0.f : wv[e][0] * qv[e]; gt += sstart ? 0.f : wg[e][0] * qg[e];
                        val += send ? 0.f : wv[e][2] * rv[e]; gt += send ? 0.f : wg[e][2] * rg[e];
                        h[e] = siluf(gt) * val; }
                    if (valid) { u32x2 w; w.x = cvt_pk_bf16(h[0], h[1]); w.y = cvt_pk_bf16(h[2], h[3]); *(u32x2*)(O + (size_t)tok * ldc + colh + 4 * n) = w; }
                }
            }
        }
    }
    __device__ __forceinline__ void convs_epi(const f32x4 (&acc)[2][2][4][2], const Unit& u, int wr, int wc, int fr, int fq) const {
        const int lane = fr | (fq << 4);
        const int tokb = 250 * u.pm - 2 + 125 * wr + 8 * fr;
        if (u.pn == 12) {
            const int cc = 32 * wc + 8 * fq;
            if (cc < 64) {
#pragma unroll
                for (int q = 0; q < 8; ++q) { const int tb = 8 * fr + q, tok = tokb + q;
                    if (tb >= 2 && tb <= 126 && tok >= 0 && tok < Mrows) {
#pragma unroll
                        for (int n = 0; n < 2; ++n) { const f32x4 v = acc[q >> 2][0][q & 3][n]; const f32x4 b4 = *(const f32x4*)(dtb + cc + 4 * n); f32x4 o;
#pragma unroll
                            for (int e = 0; e < 4; ++e) { const float a = v[e] + b4[e]; o[e] = a > 20.f ? a : __logf(1.f + __expf(a)); }
                            *(f32x4*)(dt + (size_t)tok * 64 + cc + 4 * n) = o; } } }
            }
            return;
        }
        unsigned fvalid = 0u, fs0 = 0u, fs1 = 0u, fse = 0u;
#pragma unroll
        for (int q = 0; q < 8; ++q) { const int tb = 8 * fr + q, tok = tokb + q; const int j = tok % RPB;
            fvalid |= ((tb >= 2 && tb <= 126 && tok >= 0 && tok < Mrows) ? 1u : 0u) << q;
            fs0 |= (((j == 0) || (j == CTXL)) ? 1u : 0u) << q; fs1 |= (((j == 1) || (j == CTXL + 1)) ? 1u : 0u) << q; fse |= (((j == CTXL - 1) || (j == RPB - 1)) ? 1u : 0u) << q; }
#pragma unroll
        for (int bj = 0; bj < 2; ++bj)
#pragma unroll
            for (int n = 0; n < 2; ++n) {
                const int c0 = u.pn * BM + bj * HALF + wc * 32 + 8 * fq + 4 * n;
                float w[4][4], bb[4];
#pragma unroll
                for (int e = 0; e < 4; ++e) { const f32x4 q4 = *(const f32x4*)(cw + (size_t)(c0 + e) * 4); w[e][0] = q4.x; w[e][1] = q4.y; w[e][2] = q4.z; w[e][3] = q4.w; bb[e] = cbias[c0 + e]; }
                f32x4 p2, p3, nx;
#pragma unroll
                for (int e = 0; e < 4; ++e) { p2[e] = shx(acc[1][bj][2][n][e], 0, lane - 1); p3[e] = shx(acc[1][bj][3][n][e], 0, lane - 1); nx[e] = shx(acc[0][bj][0][n][e], 0, lane + 1); }
#pragma unroll
                for (int q = 0; q < 8; ++q) {
                    const int tok = tokb + q;
                    const bool valid = (fvalid >> q) & 1u, s0 = (fs0 >> q) & 1u, s1 = (fs1 >> q) & 1u, se = (fse >> q) & 1u;
                    const f32x4 u0 = acc[q >> 2][bj][q & 3][n];
                    const f32x4 um2 = q >= 2 ? acc[(q >= 2 ? q - 2 : 0) >> 2][bj][(q >= 2 ? q - 2 : 0) & 3][n] : (q == 0 ? p2 : p3);
                    const f32x4 um1 = q >= 1 ? acc[(q >= 1 ? q - 1 : 0) >> 2][bj][(q >= 1 ? q - 1 : 0) & 3][n] : p3;
                    const f32x4 up1 = q <= 6 ? acc[(q <= 6 ? q + 1 : 7) >> 2][bj][(q <= 6 ? q + 1 : 7) & 3][n] : nx;
                    float o[4];
#pragma unroll
                    for (int e = 0; e < 4; ++e) { float a = bb[e] + w[e][2] * u0[e];
                        a += (s0 || s1) ? 0.f : w[e][0] * um2[e]; a += s0 ? 0.f : w[e][1] * um1[e]; a += se ? 0.f : w[e][3] * up1[e]; o[e] = siluf(a); }
                    if (valid) { u32x2 pk; pk.x = cvt_pk_bf16(o[0], o[1]); pk.y = cvt_pk_bf16(o[2], o[3]); *(u32x2*)(O + (size_t)tok * ldc + c0) = pk; }
                }
            }
    }
    __device__ __forceinline__ void operator()(const f32x4 (&acc)[2][2][4][2], const Unit& u, int wr, int wc, int fr, int fq) const {
        if (mode == 4) { conv_epi(acc, u, wr, wc, fr, fq); return; }
        if (mode == 5) { convs_epi(acc, u, wr, wc, fr, fq); return; }
        const int row0 = u.pm * BM + wr * 64 + fr, col0 = u.pn * BM + wc * 32 + 8 * fq;
#define EPI_ROW(ai, m) row_op(acc[ai][0][m][0], acc[ai][0][m][1], acc[ai][1][m][0], acc[ai][1][m][1], row0 + (ai) * HALF + (m) * 16, col0, u.pn, fq)
        EPI_ROW(0, 0); EPI_ROW(0, 1); EPI_ROW(0, 2); EPI_ROW(0, 3); EPI_ROW(1, 0); EPI_ROW(1, 1); EPI_ROW(1, 2); EPI_ROW(1, 3);
#undef EPI_ROW
    }
};

template <class Epi, class Sched>
__device__ __forceinline__ void gemm_phase(LAS unsigned char* lds, const Gemm g, const Sched& S, const Epi& E, const int tidx_) {
    const int tid = tidx_, wid = __builtin_amdgcn_readfirstlane(tid >> 6), lane = tid & 63, wr = wid >> 2, wc = wid & 3, fr = lane & 15, fq = lane >> 4;
    const int K = g.K, nt = K / BK, lda = g.lda;
    unsigned voffA[2], voffB[2];
#pragma unroll
    for (int i = 0; i < 2; ++i) { int R, C; stage_rc(tid * 16 + i * 8192, R, C); const int Rb = Epi::PERM ? ((R & ~31) + perm32(R & 31)) : R;
        const int Ra = g.cmode == 1 ? 62 * (R >> 6) + 4 * (R & 15) + ((R >> 4) & 3)
                     : g.cmode == 2 ? 125 * (R >> 6) + 8 * (R & 15) + ((R >> 4) & 3) : R;
        voffA[i] = (unsigned)(Ra * lda + C) * 2u; voffB[i] = (unsigned)(Rb * K + C) * 2u; }
    const size_t kstep = (size_t)(BK * 2);
    const size_t hstepA = (size_t)(g.cmode == 1 ? 124 : g.cmode == 2 ? 4 : HALF) * lda * 2, hstepB = (size_t)HALF * K * 2;
    const char* Abase = (const char*)g.A - (size_t)g.cmode * lda * 2;
    const size_t tstepA = (size_t)(g.cmode == 1 ? 248 : g.cmode == 2 ? 250 : BM) * lda * 2, tstepB = 2 * hstepB;
    const unsigned ldsw = (unsigned)wid * 1024u;
    const int aoff = lds_byte(wr * 64 + fr, fq * 8), boff = lds_byte(wc * 32 + fr, fq * 8);
#define PG8_SA(b, h) (((b) * 2 + (h)) * HTB)
#define PG8_SB(b, h) ((4 + (b) * 2 + (h)) * HTB)
#define PG8_STAGE(bufoff, gbase, voff) do { _Pragma("unroll") for (int _i = 0; _i < 2; ++_i) \
        __builtin_amdgcn_global_load_lds((const unsigned*)((const char*)(gbase) + (voff)[_i]), (LAS unsigned*)(lds + (bufoff) + ldsw + _i * 8192), 16, 0, 0); } while (0)
#define PG8_LDA(dst, b, h) do { _Pragma("unroll") for (int m = 0; m < 4; ++m) _Pragma("unroll") for (int k = 0; k < 2; ++k) dst[m][k] = *(const LAS bf16x8*)(lds + PG8_SA(b, h) + aoff + m * 2048 + k * 1024); } while (0)
#define PG8_LDB(dst, b, h) do { _Pragma("unroll") for (int n = 0; n < 2; ++n) _Pragma("unroll") for (int k = 0; k < 2; ++k) dst[n][k] = *(const LAS bf16x8*)(lds + PG8_SB(b, h) + boff + n * 2048 + k * 1024); } while (0)
#define PG8_MMA(ai, bj, At, Bt) do { __builtin_amdgcn_s_setprio(1); _Pragma("unroll") for (int m = 0; m < 4; ++m) _Pragma("unroll") for (int n = 0; n < 2; ++n) _Pragma("unroll") for (int k = 0; k < 2; ++k) \
        acc[ai][bj][m][n] = __builtin_amdgcn_mfma_f32_16x16x32_bf16(Bt[n][k], At[m][k], acc[ai][bj][m][n], 0, 0, 0); __builtin_amdgcn_s_setprio(0); } while (0)
#define PG8_WAIT_V(n) asm volatile("s_waitcnt vmcnt(" #n ")" ::: "memory")
#define PG8_WAIT_L(n) asm volatile("s_waitcnt lgkmcnt(" #n ")" ::: "memory")
#define PG8_BAR __builtin_amdgcn_s_barrier()
#define PG8_SCHED __builtin_amdgcn_sched_barrier(0)
    Unit cur, nxt; int ui = 0;
    if (!S.next(0, cur)) return;
    f32x4 acc[2][2][4][2];
#pragma unroll
    for (int a = 0; a < 2; ++a)
#pragma unroll
        for (int b = 0; b < 2; ++b)
#pragma unroll
            for (int m = 0; m < 4; ++m)
#pragma unroll
                for (int n = 0; n < 2; ++n) acc[a][b][m][n] = (f32x4){0.f, 0.f, 0.f, 0.f};
    bf16x8 At[4][2], B0[2][2], B1[2][2];
    const char* cA = Abase + (size_t)tile_a(g, cur.pm) * tstepA; const char* cB = (const char*)g.Bt + (size_t)cur.pn * tstepB;
    PG8_STAGE(PG8_SB(0, 0), cB, voffB); PG8_STAGE(PG8_SB(0, 1), cB + hstepB, voffB); PG8_STAGE(PG8_SA(0, 0), cA, voffA); PG8_STAGE(PG8_SA(0, 1), cA + hstepA, voffA);
    if (wr == 1) PG8_BAR;
    PG8_WAIT_V(2); PG8_BAR;
    PG8_STAGE(PG8_SB(1, 0), cB + kstep, voffB); PG8_STAGE(PG8_SA(1, 0), cA + kstep, voffA); PG8_STAGE(PG8_SB(1, 1), cB + hstepB + kstep, voffB);
    PG8_WAIT_V(6); PG8_BAR;
    for (;;) {
        const bool has_next = S.next(ui + 1, nxt);
        const char* nA = has_next ? Abase + (size_t)tile_a(g, nxt.pm) * tstepA : cA; const char* nB = has_next ? (const char*)g.Bt + (size_t)nxt.pn * tstepB : cB;
        for (int t = 0; t < nt; t += 2) {
            const bool last = (t == nt - 2);
            const char* a1 = cA + (size_t)(t + 1) * kstep;
            const char* a2 = last ? nA : cA + (size_t)(t + 2) * kstep; const char* b2 = last ? nB : cB + (size_t)(t + 2) * kstep;
            const char* a3 = a2 + kstep; const char* b3 = b2 + kstep;
            PG8_LDB(B0, 0, 0); PG8_LDB(B1, 0, 1); PG8_SCHED; PG8_LDA(At, 0, 0); PG8_STAGE(PG8_SA(1, 1), a1 + hstepA, voffA);
            PG8_WAIT_V(8); PG8_WAIT_L(0); PG8_BAR; PG8_MMA(0, 0, At, B0); PG8_MMA(0, 1, At, B1); PG8_BAR; PG8_SCHED;
            PG8_LDA(At, 0, 1); PG8_STAGE(PG8_SB(0, 0), b2, voffB); PG8_STAGE(PG8_SB(0, 1), b2 + hstepB, voffB); PG8_STAGE(PG8_SA(0, 0), a2, voffA);
            PG8_WAIT_V(8); PG8_WAIT_L(0); PG8_BAR; PG8_MMA(1, 0, At, B0); PG8_MMA(1, 1, At, B1); PG8_BAR; PG8_SCHED;
            PG8_LDB(B0, 1, 0); PG8_LDB(B1, 1, 1); PG8_SCHED; PG8_LDA(At, 1, 0); PG8_STAGE(PG8_SA(0, 1), a2 + hstepA, voffA);
            PG8_WAIT_V(8); PG8_WAIT_L(0); PG8_BAR; PG8_MMA(0, 0, At, B0); PG8_MMA(0, 1, At, B1); PG8_BAR; PG8_SCHED;
            PG8_LDA(At, 1, 1); PG8_STAGE(PG8_SB(1, 0), b3, voffB); PG8_STAGE(PG8_SB(1, 1), b3 + hstepB, voffB); PG8_STAGE(PG8_SA(1, 0), a3, voffA);
            PG8_WAIT_V(8); PG8_WAIT_L(0); PG8_BAR; PG8_MMA(1, 0, At, B0); PG8_MMA(1, 1, At, B1); PG8_BAR; PG8_SCHED;
        }
        if (wr == 0) PG8_BAR;
        E(acc, cur, wr, wc, fr, fq);
        if (!has_next) break;
#pragma unroll
        for (int a = 0; a < 2; ++a)
#pragma unroll
            for (int b = 0; b < 2; ++b)
#pragma unroll
                for (int m = 0; m < 4; ++m)
#pragma unroll
                    for (int n = 0; n < 2; ++n) acc[a][b][m][n] = (f32x4){0.f, 0.f, 0.f, 0.f};
        cur = nxt; cA = nA; cB = nB; ++ui;
        if (wr == 1) PG8_BAR;
    }
    PG8_WAIT_V(0);
    PG8_BAR;
#undef PG8_SA
#undef PG8_SB
#undef PG8_STAGE
#undef PG8_LDA
#undef PG8_LDB
#undef PG8_MMA
#undef PG8_WAIT_V
#undef PG8_WAIT_L
#undef PG8_BAR
#undef PG8_SCHED
}
}

namespace att {
constexpr int D = 128, NW = 8, QBLK = 32, KVBLK = 64;
constexpr float SCALE = 0.088388347648318440f;
constexpr float THR = 8.f;
constexpr int LDQ = INA, LDK = INA, LDO = DM;
constexpr size_t SHM_V = KVBLK * D * 2, SHM_K = KVBLK * D * 2;
#define KSWZ(row, colB) ((row) * 256 + ((colB) ^ (((row) & 7) << 4)))
#define SBAR() __builtin_amdgcn_sched_barrier(0)
__device__ __forceinline__ int crow(int r, int hi) { return (r & 3) + 8 * (r >> 2) + 4 * hi; }
__device__ __forceinline__ void partialSM(f32x16& p0, f32x16& p1, float& m_reg, float& mn, float& alpha) {
    constexpr float C = SCALE * 1.4426950408889634f;
    float pmax = p0[0];
#pragma unroll
    for (int r = 1; r < 16; ++r) pmax = fmaxf(pmax, p0[r]);
#pragma unroll
    for (int r = 0; r < 16; ++r) pmax = fmaxf(pmax, p1[r]);
    { auto rr = __builtin_amdgcn_permlane32_swap(__float_as_uint(pmax), __float_as_uint(pmax), false, false);
      pmax = fmaxf(__uint_as_float(rr[0]), __uint_as_float(rr[1])); }
    if (__builtin_expect(__all(pmax - m_reg <= THR / SCALE), 1)) { mn = m_reg; alpha = 1.f; }
    else { mn = fmaxf(m_reg, pmax); alpha = __builtin_amdgcn_exp2f((m_reg - mn) * C); m_reg = mn; }
    float mnC = -mn * C;
#pragma unroll
    for (int r = 0; r < 16; ++r) p0[r] = fmaf(p0[r], C, mnC);
#pragma unroll
    for (int r = 0; r < 16; ++r) p1[r] = fmaf(p1[r], C, mnC);
#pragma unroll
    for (int r = 0; r < 16; ++r) p0[r] = __builtin_amdgcn_exp2f(p0[r]);
}
#define PK4(P, BASE, OUT) do { unsigned a0 = cvt_pk_bf16(P[BASE + 0], P[BASE + 1]), a1 = cvt_pk_bf16(P[BASE + 2], P[BASE + 3]);   \
    unsigned b0 = cvt_pk_bf16(P[BASE + 4], P[BASE + 5]), b1 = cvt_pk_bf16(P[BASE + 6], P[BASE + 7]);                              \
    auto r0 = __builtin_amdgcn_permlane32_swap(a0, b0, false, false); auto r1 = __builtin_amdgcn_permlane32_swap(a1, b1, false, false); \
    u32x4 w = {r0[0], r1[0], r0[1], r1[1]}; OUT = *reinterpret_cast<bf16x8*>(&w); } while (0)
__device__ __forceinline__ void finishSM(f32x16& p0, f32x16& p1, float alpha, float& l_reg, bf16x8& pa0, bf16x8& pa1, bf16x8& pa2, bf16x8& pa3) {
#pragma unroll
    for (int r = 0; r < 16; ++r) p1[r] = __builtin_amdgcn_exp2f(p1[r]);
    float ps = 0;
#pragma unroll
    for (int r = 0; r < 16; ++r) ps += p0[r];
#pragma unroll
    for (int r = 0; r < 16; ++r) ps += p1[r];
    { auto rr = __builtin_amdgcn_permlane32_swap(__float_as_uint(ps), __float_as_uint(ps), false, false);
      ps = __uint_as_float(rr[0]) + __uint_as_float(rr[1]); }
    l_reg = l_reg * alpha + ps;
    PK4(p0, 0, pa0); PK4(p0, 8, pa1); PK4(p1, 0, pa2); PK4(p1, 8, pa3);
}
__device__ __forceinline__ void qkt(f32x16& p0, f32x16& p1, const bf16_t* Ks, const bf16x8* qr, int r32, int hi) {
    p0 = f32x16{}; p1 = f32x16{};
#pragma unroll
    for (int d0 = 0; d0 < 8; ++d0) { int cb = (d0 * 16 + hi * 8) * 2;
        bf16x8 b0 = *reinterpret_cast<const bf16x8*>((const char*)Ks + KSWZ(r32, cb));
        bf16x8 b1 = *reinterpret_cast<const bf16x8*>((const char*)Ks + KSWZ(32 + r32, cb));
        p0 = __builtin_amdgcn_mfma_f32_32x32x16_bf16(b0, qr[d0], p0, 0, 0, 0);
        p1 = __builtin_amdgcn_mfma_f32_32x32x16_bf16(b1, qr[d0], p1, 0, 0, 0); }
}
__device__ __forceinline__ int v_st(int k, int c) { const int kk = (k & ~0xC) | ((k & 4) << 1) | ((k & 8) >> 1); return ((kk >> 3) * 4 + (c >> 5)) * 512 + ((kk & 7) * 32 + (c & 31)) * 2; }
__device__ __forceinline__ int v_rd_base(int lane) { return ((lane & 3) << 3) | (((lane >> 2) & 3) << 6) | (((lane >> 4) & 1) << 5) | (((lane >> 5) & 1) << 8); }
constexpr int v_rd_off(int d0, int ks, int half) { return d0 * 512 + ks * 4096 + half * 2048; }
template <int OFF> __device__ __forceinline__ s16x4 tr_read(int vb) {
    s16x4 r; asm volatile("ds_read_b64_tr_b16 %0, %1 offset:%2" : "=&v"(r) : "v"(vb), "i"(OFF) : "memory"); return r;
}
template <int D0> __device__ __forceinline__ void pv_one(f32x16& od, int vb, bf16x8 pa0, bf16x8 pa1, bf16x8 pa2, bf16x8 pa3) {
    const s16x4 l0 = tr_read<v_rd_off(D0, 0, 0)>(vb), h0 = tr_read<v_rd_off(D0, 0, 1)>(vb), l1 = tr_read<v_rd_off(D0, 1, 0)>(vb), h1 = tr_read<v_rd_off(D0, 1, 1)>(vb);
    const s16x4 l2 = tr_read<v_rd_off(D0, 2, 0)>(vb), h2 = tr_read<v_rd_off(D0, 2, 1)>(vb), l3 = tr_read<v_rd_off(D0, 3, 0)>(vb), h3 = tr_read<v_rd_off(D0, 3, 1)>(vb);
    asm volatile("s_waitcnt lgkmcnt(0)" ::: "memory"); SBAR();
#define PKV(L, H) (bf16x8){L[0], L[1], L[2], L[3], H[0], H[1], H[2], H[3]}
    od = __builtin_amdgcn_mfma_f32_32x32x16_bf16(pa0, PKV(l0, h0), od, 0, 0, 0);
    od = __builtin_amdgcn_mfma_f32_32x32x16_bf16(pa1, PKV(l1, h1), od, 0, 0, 0);
    od = __builtin_amdgcn_mfma_f32_32x32x16_bf16(pa2, PKV(l2, h2), od, 0, 0, 0);
    od = __builtin_amdgcn_mfma_f32_32x32x16_bf16(pa3, PKV(l3, h3), od, 0, 0, 0);
#undef PKV
}
__device__ __forceinline__ void pv_d0(f32x16* o, int vb, bf16x8 pa0, bf16x8 pa1, bf16x8 pa2, bf16x8 pa3) {
    pv_one<0>(o[0], vb, pa0, pa1, pa2, pa3); pv_one<1>(o[1], vb, pa0, pa1, pa2, pa3); pv_one<2>(o[2], vb, pa0, pa1, pa2, pa3); pv_one<3>(o[3], vb, pa0, pa1, pa2, pa3);
}

__device__ __forceinline__ void attn_dense_body(const bf16_t* __restrict__ Qb, const bf16_t* __restrict__ Kh, const bf16_t* __restrict__ Vh,
                                                bf16_t* __restrict__ Ob, int seq, char* lds, const int tidx_) {
    const int tid = tidx_, wid = tid >> 6, lane = tid & 63, r32 = lane & 31, hi = lane >> 5;
    bf16_t* V_lds = (bf16_t*)lds; bf16_t* K_lds = (bf16_t*)(lds + 2 * SHM_V);
    float* ws = (float*)(lds + 2 * SHM_V + 2 * SHM_K) + wid * 64; float* li_l = ws; float* al_l = ws + 32;
    float m_reg = -1e30f, l_reg = 0; f32x16 o[4] = {}; bf16x8 qr[8];
    const bf16_t* Qw = Qb + (long)(wid * QBLK + r32) * LDQ + hi * 8;
#pragma unroll
    for (int d0 = 0; d0 < 8; ++d0) qr[d0] = *reinterpret_cast<const bf16x8*>(Qw + d0 * 16);
    const int sr = tid >> 4, sc = (tid & 15) * 8, vst0 = v_st(sr, sc), vst1 = v_st(32 + sr, sc);
    const int vb0 = (int)(uintptr_t)V_lds + v_rd_base(lane);
    struct { bf16x8 vs0, vs1, ks0, ks1; } sr_[2];
    const unsigned rowoff = (unsigned)(sr * LDK + sc) * 2u;
#define SLOAD(i, k0) do { const unsigned o_ = rowoff + (unsigned)(k0) * (unsigned)(LDK * 2); \
    sr_[i].vs0 = *reinterpret_cast<const bf16x8*>((const char*)Vh + o_); sr_[i].vs1 = *reinterpret_cast<const bf16x8*>((const char*)Vh + o_ + 32u * LDK * 2u); \
    sr_[i].ks0 = *reinterpret_cast<const bf16x8*>((const char*)Kh + o_); sr_[i].ks1 = *reinterpret_cast<const bf16x8*>((const char*)Kh + o_ + 32u * LDK * 2u); } while (0)
#define SWRITE(b, i) do { *(bf16x8*)((char*)V_lds + (b) * SHM_V + vst0) = sr_[i].vs0;          \
    *(bf16x8*)((char*)V_lds + (b) * SHM_V + vst1) = sr_[i].vs1; int kc = sc * 2;               \
    *(bf16x8*)((char*)K_lds + (b) * SHM_K + KSWZ(sr, kc)) = sr_[i].ks0;                       \
    *(bf16x8*)((char*)K_lds + (b) * SHM_K + KSWZ(32 + sr, kc)) = sr_[i].ks1; } while (0)
#define SWAIT() asm volatile("s_waitcnt vmcnt(4)" ::: "memory")
#define RESC(a) do { if (__any((a) < 1.f)) { if (hi == 0) al_l[r32] = (a); asm volatile("s_waitcnt lgkmcnt(0)" ::: "memory"); \
    _Pragma("unroll") for (int d = 0; d < 4; ++d) _Pragma("unroll") for (int r = 0; r < 16; ++r) o[d][r] *= al_l[crow(r, hi)]; } } while (0)
    f32x16 pA0, pA1, pB0, pB1; float mnA, mnB, alA, alB; bf16x8 pa0, pa1, pa2, pa3; const int NT = seq / KVBLK;
    constexpr int SE = 0, SO = 1;
    SLOAD(SE, 0); asm volatile("s_waitcnt vmcnt(0)" ::: "memory"); SWRITE(0, SE); __syncthreads();
    qkt(pA0, pA1, K_lds, qr, r32, hi); partialSM(pA0, pA1, m_reg, mnA, alA);
    SLOAD(SO, KVBLK); if (2 < NT) SLOAD(SE, 2 * KVBLK);
    SWAIT(); SWRITE(1, SO); __syncthreads();
    for (int j = 1; j + 1 < NT; j += 2) {
        SBAR(); qkt(pB0, pB1, (bf16_t*)((char*)K_lds + SHM_K), qr, r32, hi);
        finishSM(pA0, pA1, alA, l_reg, pa0, pa1, pa2, pa3); SBAR();
        SLOAD(SO, (j + 2) * KVBLK); SBAR();
        pv_d0(o, vb0, pa0, pa1, pa2, pa3); partialSM(pB0, pB1, m_reg, mnB, alB);
        __syncthreads(); SWAIT(); SWRITE(0, SE);
        RESC(alB); __syncthreads();
        SBAR(); qkt(pA0, pA1, K_lds, qr, r32, hi);
        finishSM(pB0, pB1, alB, l_reg, pa0, pa1, pa2, pa3); SBAR();
        if (j + 3 < NT) SLOAD(SE, (j + 3) * KVBLK); SBAR();
        pv_d0(o, vb0 + (int)SHM_V, pa0, pa1, pa2, pa3); partialSM(pA0, pA1, m_reg, mnA, alA);
        __syncthreads(); SWAIT(); SWRITE(1, SO);
        RESC(alA); __syncthreads();
    }
    SBAR(); qkt(pB0, pB1, (bf16_t*)((char*)K_lds + SHM_K), qr, r32, hi);
    finishSM(pA0, pA1, alA, l_reg, pa0, pa1, pa2, pa3); SBAR();
    pv_d0(o, vb0, pa0, pa1, pa2, pa3); partialSM(pB0, pB1, m_reg, mnB, alB);
    __syncthreads(); RESC(alB);
    finishSM(pB0, pB1, alB, l_reg, pa0, pa1, pa2, pa3); SBAR();
    pv_d0(o, vb0 + (int)SHM_V, pa0, pa1, pa2, pa3);
    if (hi == 0) li_l[r32] = l_reg; asm volatile("s_waitcnt lgkmcnt(0)" ::: "memory");
    float rli[16];
#pragma unroll
    for (int r = 0; r < 16; ++r) rli[r] = __builtin_amdgcn_rcpf(li_l[crow(r, hi)]);
    bf16_t* Ow = Ob + (long)(wid * QBLK) * LDO;
#pragma unroll
    for (int r = 0; r < 16; ++r) { int orow = crow(r, hi);
#pragma unroll
        for (int d0 = 0; d0 < 4; ++d0) Ow[(long)orow * LDO + d0 * 32 + r32] = (bf16_t)(cvt_pk_bf16(o[d0][r] * rli[r], 0.f) & 0xffffu); }
#undef SLOAD
#undef SWRITE
#undef SWAIT
#undef RESC
}
}

__device__ __forceinline__ void p0_transpose_item(const float* W, int K, int N, bf16_t* WT, LAS float* scr, int item, int lane, const float* kscale, int ileave = 0) {
    const int nblk = N / 32, kb = item / nblk, nb = item % nblk, k0 = 64 * kb, n0 = 32 * nb;
    const int d0 = !ileave ? n0 : (n0 < DFF ? 256 * (n0 >> 7) + (n0 & 127) : 256 * ((n0 - DFF) >> 7) + 128 + ((n0 - DFF) & 127));
#pragma unroll 8
    for (int i = 0; i < 32; ++i) { const int kk = 2 * i + (lane >> 5); float v = W[(size_t)(k0 + kk) * N + n0 + (lane & 31)]; if (kscale) v *= kscale[k0 + kk]; scr[kk * 33 + (lane & 31)] = v; }
    asm volatile("s_waitcnt lgkmcnt(0)" ::: "memory");
    const int c = lane & 7;
#pragma unroll
    for (int j = 0; j < 4; ++j) { const int n = (lane >> 3) + 8 * j; const LAS float* s = scr + (8 * c) * 33 + n;
        u32x4 o; o.x = cvt_pk_bf16(s[0 * 33], s[1 * 33]); o.y = cvt_pk_bf16(s[2 * 33], s[3 * 33]); o.z = cvt_pk_bf16(s[4 * 33], s[5 * 33]); o.w = cvt_pk_bf16(s[6 * 33], s[7 * 33]);
        *(u32x4*)(WT + (size_t)(d0 + n) * K + k0 + 8 * c) = o; }
    asm volatile("s_waitcnt lgkmcnt(0)" ::: "memory");
}

__device__ __forceinline__ void phase_p0(KP P, LAS unsigned char* lds, int G, const int tidx_, const int bidx_) {
    const int tid = tidx_, wid = __builtin_amdgcn_readfirstlane(tid >> 6), lane = tid & 63;
    unsigned char* ws = P->ws;
    {
        LAS float* SC = (LAS float*)lds;
        LAS float* RED = (LAS float*)(lds + 36864);
        bool have = false;
        for (int task = bidx_; task < 192; task += G) {
            if (!have) {
                for (int idx = tid; idx < 9 * 1024; idx += 512) { const int row = idx >> 10, k = idx & 1023; const float v = row < 8 ? P->in[I_C][row * 1024 + k] : P->in[I_CCTX][k]; SC[idx] = v / (1.f + expf(-v)); }
                __syncthreads(); have = true;
            }
            const int layer = task / 96, n0 = (task % 96) * 64;
            const float* W = P->in[I_ADAW] + (size_t)layer * 1024 * 6144 + n0 + lane;
            float a[9];
#pragma unroll
            for (int r = 0; r < 9; ++r) a[r] = 0.f;
            const int kbeg = wid * 128;
#pragma unroll 8
            for (int k = 0; k < 128; ++k) { const float w = W[(size_t)(kbeg + k) * 6144];
#pragma unroll
                for (int r = 0; r < 9; ++r) a[r] += SC[r * 1024 + kbeg + k] * w; }
#pragma unroll
            for (int r = 0; r < 9; ++r) RED[(wid * 9 + r) * 64 + lane] = a[r];
            __syncthreads();
            for (int idx = tid; idx < 576; idx += 512) { const int r = idx >> 6, l = idx & 63; float s = P->in[I_ADAB][layer * 6144 + n0 + l];
#pragma unroll
                for (int w = 0; w < 8; ++w) s += RED[(w * 9 + r) * 64 + l];
                ((float*)(ws + WS_MOD))[(layer * 9 + r) * 6144 + n0 + l] = s; }
            __syncthreads();
        }
        __syncthreads();
    }
    {
        const int gt = bidx_ * 512 + tid, NT = G * 512;
        float* rs = (float*)(ws + WS_ROWSS);
        for (int i = gt; i < MT; i += NT) rs[i] = 0.f;
        u32x4* pz = (u32x4*)(ws + W_SIN + (size_t)INC * 1024 * 2);
        for (int i = gt; i < (SINP - INC) * 1024 / 8; i += NT) pz[i] = (u32x4){0u, 0u, 0u, 0u};
    }
    {
        LAS float* scr = (LAS float*)(lds + wid * 8448);
        const int gw = bidx_ * 8 + wid, NGW = G * 8;
        constexpr int I0 = 16 * 48, I1 = 16 * 32, I2 = 16 * 176, I3 = 44 * 32, I4 = 16 * 162, I5 = 32 * 32;
        constexpr int NIT = I0 + I1 + 2 * I2 + 2 * I3 + I4 + I5;
        for (int it = gw; it < NIT; it += NGW) {
            int r = it;
            if (r < I0) { p0_transpose_item(P->in[I_AWIN], 1024, INA, (bf16_t*)(ws + W_AIN), scr, r, lane, nullptr); continue; } r -= I0;
            if (r < I1) { p0_transpose_item(P->in[I_AWOUT], 1024, 1024, (bf16_t*)(ws + W_AOUT), scr, r, lane, nullptr); continue; } r -= I1;
            if (r < I2) { p0_transpose_item(P->in[I_FUP], 1024, DFF2, (bf16_t*)(ws + W_UP0), scr, r, lane, nullptr, 1); continue; } r -= I2;
            if (r < I2) { p0_transpose_item(P->in[I_FUP] + (size_t)1024 * DFF2, 1024, DFF2, (bf16_t*)(ws + W_UP1), scr, r, lane, nullptr, 1); continue; } r -= I2;
            if (r < I3) { p0_transpose_item(P->in[I_FDN], DFF, 1024, (bf16_t*)(ws + W_DN0), scr, r, lane, nullptr); continue; } r -= I3;
            if (r < I3) { p0_transpose_item(P->in[I_FDN] + (size_t)DFF * 1024, DFF, 1024, (bf16_t*)(ws + W_DN1), scr, r, lane, nullptr); continue; } r -= I3;
            if (r < I4) { p0_transpose_item(P->in[I_SWIN], 1024, INC, (bf16_t*)(ws + W_SIN), scr, r, lane, nullptr); continue; } r -= I4;
            p0_transpose_item(P->in[I_SWOUT], DIN, 1024, (bf16_t*)(ws + W_SOUT), scr, r, lane, P->in[I_SNW]);
        }
    }
}

struct RwDesc { int rows, rspace, layer, layerB; const float* srcL; const float* srcC; const bf16_t* xsrc; bf16_t* xdst; float* odst; const bf16_t* Y; const float* nwA; int gate_k; const float* nwB; int shift_k, scale_k; bf16_t* XN; };
__device__ __forceinline__ void phase_rw(KP P, const RwDesc d, int G, const int tidx_, const int bidx_) {
    const int tid = tidx_, wid = tid >> 6, lane = tid & 63;
    const int gw = bidx_ * 8 + wid, NGW = G * 8;
    const float* MOD = (const float*)(P->ws + WS_MOD) + (size_t)d.layer * 9 * 6144;
    const float* MODB = (const float*)(P->ws + WS_MOD) + (size_t)d.layerB * 9 * 6144;
    const int nk = (d.rows - gw + NGW - 1) / NGW;
    const int r0 = 0, r1 = nk;
#define RW_ROW(k_) (gw + (k_) * NGW)
#define RW_SROW(r_) (d.rspace ? (r_) : (r_) + CTXL * (((r_) >> 13) + 1))
    f32x4 vnA[4], vgt[4], vnB[4], vsh[4], vsc[4]; int cur = -1;
#pragma unroll
    for (int j = 0; j < 4; ++j) { vnA[j] = d.nwA ? *(const f32x4*)(d.nwA + 4 * lane + 256 * j) : (f32x4){0.f, 0.f, 0.f, 0.f}; vnB[j] = d.nwB ? *(const f32x4*)(d.nwB + 4 * lane + 256 * j) : (f32x4){0.f, 0.f, 0.f, 0.f}; }
#define RW_ADDR(r_, src_, mrow_) do { const int rc_ = (r_); \
        if (d.rspace) { const int b_ = rc_ / RPB, j_ = rc_ - b_ * RPB; \
            if (j_ < CTXL) { src_ = d.srcC + (size_t)(b_ * CTXL + j_) * DM; mrow_ = 8; } \
            else { src_ = d.srcL + (size_t)(b_ * SEQ + j_ - CTXL) * DM; mrow_ = b_; } \
        } else { src_ = d.srcL + (size_t)rc_ * DM; mrow_ = rc_ / SEQ; } } while (0)
#define RW_LOAD(XV, XQ, YQ, rbase_) do { _Pragma("unroll") for (int k = 0; k < 2; ++k) { const int kk_ = ((rbase_) + k < r1) ? (rbase_) + k : r1 - 1; const int rc2_ = RW_ROW(kk_); \
        if (d.xsrc) { const bf16_t* s2_ = d.xsrc + (size_t)RW_SROW(rc2_) * DM; _Pragma("unroll") for (int j = 0; j < 4; ++j) XQ[k][j] = *(const u32x2*)(s2_ + 4 * lane + 256 * j); } \
        else { const float* s_; int m_; RW_ADDR(rc2_, s_, m_); (void)m_; _Pragma("unroll") for (int j = 0; j < 4; ++j) XV[k][j] = *(const f32x4*)(s_ + 4 * lane + 256 * j); } \
        if (d.Y) { _Pragma("unroll") for (int j = 0; j < 4; ++j) YQ[k][j] = *(const u32x2*)(d.Y + (size_t)rc2_ * DM + 4 * lane + 256 * j); } } } while (0)
    f32x4 xv[2][4], xn[2][4]; u32x2 xq[2][4], xqn[2][4], yq[2][4], yn[2][4];
    if (r0 < r1) RW_LOAD(xv, xq, yq, r0);
    for (int rr = r0; rr < r1; rr += 2) {
        if (rr + 2 < r1) RW_LOAD(xn, xqn, yn, rr + 2);
#pragma unroll
        for (int k = 0; k < 2; ++k) {
            if (rr + k >= r1) continue;
            const int r = RW_ROW(rr + k);
            int mrowk;
            if (d.rspace) { const int b_ = r / RPB, j_ = r - b_ * RPB; mrowk = j_ < CTXL ? 8 : b_; } else mrowk = r / SEQ;
            if (mrowk != cur) { cur = mrowk; const float* mod = MOD + (size_t)cur * 6144; const float* modb = MODB + (size_t)cur * 6144;
#pragma unroll
                for (int j = 0; j < 4; ++j) { vgt[j] = *(const f32x4*)(mod + d.gate_k * 1024 + 4 * lane + 256 * j); vsh[j] = *(const f32x4*)(modb + d.shift_k * 1024 + 4 * lane + 256 * j);
                    vsc[j] = *(const f32x4*)(modb + d.scale_k * 1024 + 4 * lane + 256 * j); } }
            if (d.xsrc) {
#pragma unroll
                for (int j = 0; j < 4; ++j) { const u32x2 q = xq[k][j]; xv[k][j] = (f32x4){bflo(q.x), bfhi(q.x), bflo(q.y), bfhi(q.y)}; }
            }
            if (d.Y) {
                f32x4 yv[4]; float ss = 0.f;
#pragma unroll
                for (int j = 0; j < 4; ++j) { const u32x2 q = yq[k][j];
                    yv[j] = (f32x4){bflo(q.x), bfhi(q.x), bflo(q.y), bfhi(q.y)}; ss += (yv[j].x * yv[j].x + yv[j].y * yv[j].y) + (yv[j].z * yv[j].z + yv[j].w * yv[j].w); }
                const float rstd = rsqrtf(wave_sum(ss, lane) * (1.f / DM) + EPS);
#pragma unroll
                for (int j = 0; j < 4; ++j) xv[k][j] = xv[k][j] + vgt[j] * (yv[j] * rstd * vnA[j]);
                if (d.xdst) { bf16_t* xd = d.xdst + (size_t)RW_SROW(r) * DM;
#pragma unroll
                    for (int j = 0; j < 4; ++j) { u32x2 o; o.x = cvt_pk_bf16(xv[k][j].x, xv[k][j].y); o.y = cvt_pk_bf16(xv[k][j].z, xv[k][j].w); *(u32x2*)(xd + 4 * lane + 256 * j) = o; }
                }
                if (d.odst) { float* od = d.odst + (size_t)r * DM;
#pragma unroll
                    for (int j = 0; j < 4; ++j) *(f32x4*)(od + 4 * lane + 256 * j) = xv[k][j];
                }
            }
            if (d.XN) {
                float ss = 0.f;
#pragma unroll
                for (int j = 0; j < 4; ++j) ss += (xv[k][j].x * xv[k][j].x + xv[k][j].y * xv[k][j].y) + (xv[k][j].z * xv[k][j].z + xv[k][j].w * xv[k][j].w);
                const float rstd = rsqrtf(wave_sum(ss, lane) * (1.f / DM) + EPS);
#pragma unroll
                for (int j = 0; j < 4; ++j) { const f32x4 h = (xv[k][j] * rstd * vnB[j]) * (vsc[j] + 1.f) + vsh[j];
                    u32x2 o; o.x = cvt_pk_bf16(h.x, h.y); o.y = cvt_pk_bf16(h.z, h.w);
                    *(u32x2*)(d.XN + (size_t)r * DM + 4 * lane + 256 * j) = o; }
            }
        }
#pragma unroll
        for (int k = 0; k < 2; ++k)
#pragma unroll
            for (int j = 0; j < 4; ++j) { xv[k][j] = xn[k][j]; xq[k][j] = xqn[k][j]; yq[k][j] = yn[k][j]; }
    }
#undef RW_ADDR
#undef RW_LOAD
#undef RW_ROW
#undef RW_SROW
}

__device__ __forceinline__ void phase_qkp(KP P, LAS unsigned char* lds, int G, const int tidx_, const int bidx_) {
    const int tid = tidx_, wid = tid >> 6, lane = tid & 63;
    bf16_t* U = (bf16_t*)(P->ws + BIG_U); bf16_t* MIX = (bf16_t*)(P->ws + BIG_MIX);
    LAS float* PW = (LAS float*)lds;
    for (int i = tid; i < 4 * 64 * 64; i += 512) PW[i] = P->in[I_POOLW][i];
    LAS float* ROPE = (LAS float*)(lds + 65536);
    for (int i = tid; i < 192 * 32; i += 512) { const int pidx = i >> 5, m = i & 31; const float pos = (float)(pidx < 128 ? pidx : pidx - 128);
        float sn, cs; sincosf(pos * powf(10000.f, -(float)m / 32.f), &sn, &cs); ROPE[2 * i] = cs; ROPE[2 * i + 1] = sn; }
    __syncthreads();
    const int head = lane >> 3, l8 = lane & 7;
    const float* gain = (head < 6 ? P->in[I_QG] : P->in[I_KG]) + l8 * 16;
    float gn[16];
#pragma unroll
    for (int e = 0; e < 16; ++e) gn[e] = gain[e];
    const bool use_row = l8 < 4;
    float psc[4];
#pragma unroll
    for (int g = 0; g < 4; ++g) psc[g] = P->in[I_POOLS][g * 64 + lane];
    const int gw = bidx_ * 8 + wid, NGW = G * 8;
    for (int r = gw; r < MR; r += NGW) {
        const int b = r / RPB, j = r - b * RPB; const bool isctx = j < CTXL;
        const int t = isctx ? j : j - CTXL, T = isctx ? CTXL : SEQ;
        bf16_t* urow = U + (size_t)r * INA;
        {
            const u32x4 q0 = *(const u32x4*)(urow + 256 + 16 * lane), q1 = *(const u32x4*)(urow + 256 + 16 * lane + 8);
            float v[16]; { float a[8], c[8]; unpack8(q0, a); unpack8(q1, c);
#pragma unroll
                for (int e = 0; e < 8; ++e) { v[e] = a[e]; v[8 + e] = c[e]; } }
            float ss = 0.f;
#pragma unroll
            for (int e = 0; e < 16; ++e) ss += v[e] * v[e];
            ss += shx(ss, 1, lane); ss += shx(ss, 2, lane); ss += shx(ss, 4, lane);
            const float rstd = rsqrtf(ss * (1.f / 128.f) + EPS);
#pragma unroll
            for (int e = 0; e < 16; ++e) v[e] = v[e] * rstd * gn[e];
            if (!isctx) {
                const int pidx = use_row ? (t >> 6) : 128 + (t & 63);
#pragma unroll
                for (int i = 0; i < 8; ++i) { const int m = (l8 & 3) * 8 + i; const float cs = ROPE[(pidx * 32 + m) * 2], sn = ROPE[(pidx * 32 + m) * 2 + 1];
                    const float x1 = v[2 * i], x2 = v[2 * i + 1]; v[2 * i] = x1 * cs - x2 * sn; v[2 * i + 1] = x1 * sn + x2 * cs; }
            }
            float a[8], c[8];
#pragma unroll
            for (int e = 0; e < 8; ++e) { a[e] = v[e]; c[e] = v[8 + e]; }
            *(u32x4*)(urow + 256 + 16 * lane) = pack8(a); *(u32x4*)(urow + 256 + 16 * lane + 8) = pack8(c);
        }
#pragma unroll
        for (int g = 0; g < 4; ++g) {
            const int w = 2 << g, left = w >> 1, right = w - 1 - left;
            const int lo = (t - left) > 0 ? (t - left) : 0, hi = (t + right) < (T - 1) ? (t + right) : (T - 1);
            float s = 0.f;
            for (int tt = lo; tt <= hi; ++tt) s += bflo((unsigned)urow[(long)(tt - t) * INA + g * 64 + lane]);
            const float self = bflo((unsigned)urow[g * 64 + lane]);
            const float part = s / (float)(hi - lo + 1) - self;
            float y = 0.f;
#pragma unroll 16
            for (int i = 0; i < 64; ++i) y += rdlane(part, i) * PW[(g * 64 + i) * 64 + lane];
            y *= psc[g];
            MIX[(size_t)r * DM + g * 64 + lane] = (bf16_t)(cvt_pk_bf16(y, 0.f) & 0xffffu);
        }
    }
}

__device__ __forceinline__ void attn_unit(KP P, char* lds, int b, int h, int qb, bool ctx, const int tidx_) {
    bf16_t* U = (bf16_t*)(P->ws + BIG_U); bf16_t* MIX = (bf16_t*)(P->ws + BIG_MIX);
    const int kvh = h / 3;
    const size_t R0 = (size_t)b * RPB, RQ = ctx ? R0 : R0 + CTXL + (size_t)qb * 256;
    att::attn_dense_body(U + RQ * INA + 256 + h * 128, U + R0 * INA + 1024 + kvh * 128, U + R0 * INA + 1280 + kvh * 128,
                         MIX + RQ * DM + 256 + h * 128, ctx ? CTXL : RPB, lds, tidx_);
    __syncthreads();
}
__device__ __forceinline__ void phase_attn(KP P, char* lds, int G, const int tidx_, const int bidx_) {
    const int bid = bidx_;
    const int nlat = (G == 256) ? 6 : (1536 - bid + G - 1) / G;
    const int nctx = (bid < 48) ? (48 - bid + G - 1) / G : 0;
    for (int i = 0; i < nlat + nctx; ++i) {
        int b, h, qb; bool ctx;
        if (i < nlat) {
            int grp, idx;
            if (G == 256) { const int xcd = bid & 7, cu = bid >> 3; grp = 2 * xcd + i / 3; idx = (i % 3) * 32 + cu; }
            else { const int u = bid + i * G; grp = u / 96; idx = u % 96; }
            b = grp >> 1; h = (grp & 1) * 3 + (idx >> 5); qb = idx & 31; ctx = false;
        } else { const int u = bid + (i - nlat) * G; b = u / 6; h = u % 6; qb = 0; ctx = true; }
        attn_unit(P, lds, b, h, qb, ctx, tidx_);
    }
}

__device__ __forceinline__ bool seq_first(int r0, int rspace) { if (rspace) { const int j = r0 % RPB; return j == 0 || j == CTXL; } return (r0 % SEQ) == 0; }
__device__ __forceinline__ bool seq_last(int r0, int rspace) { if (rspace) { const int j = (r0 + 64) % RPB; return j == 0 || j == CTXL; } return ((r0 + 64) % SEQ) == 0; }

__device__ __forceinline__ void phase_halo_f(KP P, int rows, int G, const int tidx_, const int bidx_) {
    const bf16_t* UP = (const bf16_t*)(P->ws + BIG_UP); bf16_t* HL = (bf16_t*)(P->ws + WS_HALO);
    const long total = (long)(rows / 64) * 2 * 704;
    for (long idx = (long)bidx_ * 512 + tidx_; idx < total; idx += (long)G * 512) {
        const int v = (int)(idx % 704); const long q = idx / 704; const int w = (int)(q & 1); const long rb = q >> 1;
        const long row = rb * 64 + (w ? 63 : 0);
        *(u32x4*)(HL + (size_t)q * DFF2 + 8 * v) = *(const u32x4*)(UP + (size_t)row * DFF2 + 8 * v);
    }
}
__device__ __forceinline__ void phase_cg(KP P, int rows, int rspace, int layer, int G, const int tidx_, const int bidx_) {
    bf16_t* UP = (bf16_t*)(P->ws + BIG_UP); const bf16_t* HL = (const bf16_t*)(P->ws + WS_HALO);
    const float* CW = P->in[I_FCW] + (size_t)layer * DFF2 * 3; const float* CB = P->in[I_FCB] + (size_t)layer * DFF2;
    const long total = (long)(rows / 64) * 352;
    const u32x4 Z4 = (u32x4){0u, 0u, 0u, 0u};
    for (long idx = (long)bidx_ * 512 + tidx_; idx < total; idx += (long)G * 512) {
        const int v = (int)(idx % 352); const int rb = (int)(idx / 352); const int r0 = rb * 64;
        const bool first = seq_first(r0, rspace), last = seq_last(r0, rspace);
        float wv[8][3], wg[8][3], bv[8], bg[8];
#pragma unroll
        for (int e = 0; e < 8; ++e) {
#pragma unroll
            for (int k = 0; k < 3; ++k) { wv[e][k] = CW[(8 * v + e) * 3 + k]; wg[e][k] = CW[(DFF + 8 * v + e) * 3 + k]; }
            bv[e] = CB[8 * v + e]; bg[e] = CB[DFF + 8 * v + e]; }
        u32x4 pv_ = first ? Z4 : *(const u32x4*)(HL + ((size_t)(rb - 1) * 2 + 1) * DFF2 + 8 * v);
        u32x4 pg_ = first ? Z4 : *(const u32x4*)(HL + ((size_t)(rb - 1) * 2 + 1) * DFF2 + DFF + 8 * v);
        bf16_t* base = UP + (size_t)r0 * DFF2 + 8 * v;
        u32x4 cv_ = *(const u32x4*)base, cg_ = *(const u32x4*)(base + DFF);
        u32x4 nv_ = *(const u32x4*)(base + (size_t)DFF2), ng_ = *(const u32x4*)(base + (size_t)DFF2 + DFF);
        const u32x4 hv_ = last ? Z4 : *(const u32x4*)(HL + ((size_t)(rb + 1) * 2) * DFF2 + 8 * v), hg_ = last ? Z4 : *(const u32x4*)(HL + ((size_t)(rb + 1) * 2) * DFF2 + DFF + 8 * v);
        for (int t = 0; t < 64; ++t) {
            u32x4 fv_ = hv_, fg_ = hg_;
            if (t + 2 < 64) { fv_ = *(const u32x4*)(base + (size_t)(t + 2) * DFF2); fg_ = *(const u32x4*)(base + (size_t)(t + 2) * DFF2 + DFF); }
            float a0[8], a1[8], a2[8], g0[8], g1[8], g2[8], o[8];
            unpack8(pv_, a0); unpack8(cv_, a1); unpack8(nv_, a2); unpack8(pg_, g0); unpack8(cg_, g1); unpack8(ng_, g2);
#pragma unroll
            for (int e = 0; e < 8; ++e) { const float val = bv[e] + wv[e][0] * a0[e] + wv[e][1] * a1[e] + wv[e][2] * a2[e];
                const float gt = bg[e] + wg[e][0] * g0[e] + wg[e][1] * g1[e] + wg[e][2] * g2[e]; o[e] = siluf(gt) * val; }
            *(u32x4*)(base + (size_t)t * DFF2) = pack8(o);
            pv_ = cv_; pg_ = cg_; cv_ = nv_; cg_ = ng_; nv_ = fv_; ng_ = fg_;
        }
    }
}
__device__ __forceinline__ void phase_halo_s(KP P, int G, const int tidx_, const int bidx_) {
    const bf16_t* XBC = (const bf16_t*)(P->ws + BIG_XBC); bf16_t* HL = (bf16_t*)(P->ws + WS_HALO);
    const long total = (long)(MR / 64) * 3 * 384;
    for (long idx = (long)bidx_ * 512 + tidx_; idx < total; idx += (long)G * 512) {
        const int v = (int)(idx % 384); const long q = idx / 384; const int w = (int)(q % 3); const long rb = q / 3;
        const long row = rb * 64 + (w == 0 ? 0 : 61 + w);
        *(u32x4*)(HL + (size_t)q * CONVD + 8 * v) = *(const u32x4*)(XBC + (size_t)row * CONVD + 8 * v);
    }
}
__device__ __forceinline__ void phase_conv_s(KP P, int G, const int tidx_, const int bidx_) {
    bf16_t* XBC = (bf16_t*)(P->ws + BIG_XBC); const bf16_t* HL = (const bf16_t*)(P->ws + WS_HALO);
    const float* CW = P->in[I_SCW]; const float* CB = P->in[I_SCB];
    const long total = (long)(MR / 64) * 384;
    const u32x4 Z4 = (u32x4){0u, 0u, 0u, 0u};
    for (long idx = (long)bidx_ * 512 + tidx_; idx < total; idx += (long)G * 512) {
        const int v = (int)(idx % 384); const int rb = (int)(idx / 384); const int r0 = rb * 64;
        const bool first = seq_first(r0, 1), last = seq_last(r0, 1);
        float w[8][4], bb[8];
#pragma unroll
        for (int e = 0; e < 8; ++e) { const f32x4 q = *(const f32x4*)(CW + (size_t)(8 * v + e) * 4); w[e][0] = q.x; w[e][1] = q.y; w[e][2] = q.z; w[e][3] = q.w; bb[e] = CB[8 * v + e]; }
        u32x4 pp = first ? Z4 : *(const u32x4*)(HL + ((size_t)(rb - 1) * 3 + 1) * CONVD + 8 * v);
        u32x4 p1 = first ? Z4 : *(const u32x4*)(HL + ((size_t)(rb - 1) * 3 + 2) * CONVD + 8 * v);
        bf16_t* base = XBC + (size_t)r0 * CONVD + 8 * v;
        u32x4 cu = *(const u32x4*)base, nx = *(const u32x4*)(base + (size_t)CONVD);
        const u32x4 hx = last ? Z4 : *(const u32x4*)(HL + ((size_t)(rb + 1) * 3) * CONVD + 8 * v);
        for (int t = 0; t < 64; ++t) {
            u32x4 fx = hx;
            if (t + 2 < 64) fx = *(const u32x4*)(base + (size_t)(t + 2) * CONVD);
            float a0[8], a1[8], a2[8], a3[8], o[8];
            unpack8(pp, a0); unpack8(p1, a1); unpack8(cu, a2); unpack8(nx, a3);
#pragma unroll
            for (int e = 0; e < 8; ++e) { const float a = bb[e] + w[e][0] * a0[e] + w[e][1] * a1[e] + w[e][2] * a2[e] + w[e][3] * a3[e]; o[e] = siluf(a); }
            *(u32x4*)(base + (size_t)t * CONVD) = pack8(o);
            pp = p1; p1 = cu; cu = nx; nx = fx;
        }
    }
}

__device__ __forceinline__ unsigned offb(unsigned R, unsigned ch) { return 256u * R + 16u * (ch ^ (((R & 3u) << 2) | ((R >> 2) & 3u))); }
__device__ __forceinline__ bf16x8 rowfrag(LAS const unsigned char* tile, int rb, int s, int lane) {
    return *(LAS const bf16x8*)(tile + offb(32 * rb + (lane & 31), 2 * s + (lane >> 5)));
}
__device__ __forceinline__ s16x4 trd(LAS const unsigned char* p) { return __builtin_bit_cast(s16x4, __builtin_amdgcn_ds_read_tr16_b64_v4i16((LAS v4i16_t*)p)); }
__device__ __forceinline__ bf16x8 trfrag(LAS const unsigned char* tile, int c, int ks, int lane) {
    const unsigned h = lane >> 5, blk = (lane >> 4) & 1, q = (lane & 15) >> 2, p = lane & 3;
    const unsigned ch = 4 * c + 2 * blk + (p >> 1), r0 = 16 * ks + 8 * h + q;
    const s16x4 lo = trd(tile + offb(r0, ch) + 8 * (p & 1)), hi = trd(tile + offb(r0 + 4, ch) + 8 * (p & 1));
    return (bf16x8){lo[0], lo[1], lo[2], lo[3], hi[0], hi[1], hi[2], hi[3]};
}

__device__ __forceinline__ void phase_ssd(KP P, LAS unsigned char* lds, int G, const int tidx_, const int bidx_) {
    const int tid = tidx_, wid = __builtin_amdgcn_readfirstlane(tid >> 6), lane = tid & 63, r32 = lane & 31, hi = lane >> 5;
    LAS unsigned char* BT = lds; LAS unsigned char* CT = lds + 32768; LAS unsigned char* X2 = lds + 65536; LAS unsigned char* HS = lds + 98304;
    LAS float* sarr = (LAS float*)(lds + 114688);
    LAS float* YST = (LAS float*)(lds + 118784);
    const bf16_t* XBC = (const bf16_t*)(P->ws + BIG_XBC); const float* DT = (const float*)(P->ws + BIG_DT); bf16_t* YS = (bf16_t*)(P->ws + BIG_YS);
    const int lb = (wid < 4) ? (wid >> 1) : (wid < 6 ? 3 : 2), pb = wid & 1;
    for (int u = bidx_; u < NB * 32; u += G) {
        const int b = (G == 256) ? (u & 7) : (u >> 5), h = (G == 256) ? (u >> 3) : (u & 31), g = h >> 3;
        const float Dk = P->in[I_SD][h];
        for (int dir = 0; dir < 2; ++dir) {
            const float A = -expf(P->in[I_SALOG][dir * 32 + h]);
            const int sgn = dir ? -1 : 1;
            f32x16 hacc = {};
            for (int i = tid; i < 1024; i += 512) *(LAS u32x4*)(HS + 16 * i) = (u32x4){0u, 0u, 0u, 0u};
            u32x4 pfB[4], pfC[4], pfX[2]; float dA0 = 0.f, dA1 = 0.f, dB0 = 0.f, dB1 = 0.f;
#define SSD_J0(c) ((c) < 2 ? (dir ? 255 - 128 * (c) : 128 * (c)) : (dir ? 8447 - 128 * ((c) - 2) : 256 + 128 * ((c) - 2)))
#define SSD_PREFETCH(c) do { const int j0_ = SSD_J0(c); const size_t rbase_ = (size_t)b * RPB; \
    _Pragma("unroll") for (int i = 0; i < 4; ++i) { const int v = tid + 512 * i, l = v >> 4, ch = v & 15; const bf16_t* rp = XBC + (rbase_ + j0_ + sgn * l) * CONVD; \
        pfB[i] = *(const u32x4*)(rp + 2048 + g * 128 + 8 * ch); pfC[i] = *(const u32x4*)(rp + 2560 + g * 128 + 8 * ch); } \
    _Pragma("unroll") for (int i = 0; i < 2; ++i) { const int v = tid + 512 * i, l = v >> 3, xc = v & 7; pfX[i] = *(const u32x4*)(XBC + (rbase_ + j0_ + sgn * l) * CONVD + h * 64 + 8 * xc); } \
    } while (0)
#define SSD_LOADDT(c_, d0_, d1_) do { const int jd_ = SSD_J0(c_); const size_t rb_ = (size_t)b * RPB; \
    d0_ = DT[(rb_ + jd_ + sgn * (2 * lane)) * 64 + dir * 32 + h]; d1_ = DT[(rb_ + jd_ + sgn * (2 * lane + 1)) * 64 + dir * 32 + h]; } while (0)
#define SSD_SCAN(buf_, pfd0, pfd1) do { LAS float* ac_ = sarr + (buf_) * 512; const float a0 = pfd0 * A, a1 = pfd1 * A; float incl = a0 + a1; \
    _Pragma("unroll") for (int o = 1; o < 64; o <<= 1) { const float t = shup(incl, o, lane); if (lane >= o) incl += t; } \
    const float tot = rdlane(incl, 63); const float c0 = incl - a1; \
    ac_[2 * lane] = c0; ac_[2 * lane + 1] = incl; ac_[128 + 2 * lane] = __expf(c0); ac_[128 + 2 * lane + 1] = __expf(incl); \
    ac_[256 + 2 * lane] = pfd0; ac_[256 + 2 * lane + 1] = pfd1; ac_[384 + 2 * lane] = __expf(tot - c0); ac_[384 + 2 * lane + 1] = __expf(tot - incl); } while (0)
#define SSD_TILES(buf_) do { LAS float* dtv_ = sarr + (buf_) * 512 + 256; LAS float* wdec_ = dtv_ + 128; \
    _Pragma("unroll") for (int i = 0; i < 4; ++i) { const int v = tid + 512 * i, l = v >> 4, ch = v & 15; *(LAS u32x4*)(BT + offb(l, ch)) = pfB[i]; *(LAS u32x4*)(CT + offb(l, ch)) = pfC[i]; } \
    _Pragma("unroll") for (int i = 0; i < 2; ++i) { const int v = tid + 512 * i, l = v >> 3, xc = v & 7; float f[8], xd[8], xw[8]; unpack8(pfX[i], f); const float d = dtv_[l], w = wdec_[l]; \
        _Pragma("unroll") for (int e = 0; e < 8; ++e) { xd[e] = f[e] * d; xw[e] = xd[e] * w; } \
        *(LAS u32x4*)(X2 + offb(l, xc)) = pack8(xd); *(LAS u32x4*)(X2 + offb(l, 8 + xc)) = pack8(xw); } } while (0)
            SSD_PREFETCH(0);
            if (wid == 0) { SSD_LOADDT(0, dA0, dA1); SSD_LOADDT(1, dB0, dB1); SSD_SCAN(0, dA0, dA1); SSD_LOADDT(2, dA0, dA1); }
            __syncthreads();
            SSD_TILES(0);
            SSD_PREFETCH(1);
            __syncthreads();
            for (int c = 0; c < 66; ++c) {
                const int j0 = SSD_J0(c);
                const bool outp = c >= 2;
                LAS float* acum = sarr + (c & 1) * 512; LAS float* eac = acum + 128;
                if (wid == 0 && c + 1 < 66) {
                    if ((c + 1) & 1) { SSD_SCAN(1, dB0, dB1); if (c + 3 < 66) SSD_LOADDT(c + 3, dB0, dB1); }
                    else { SSD_SCAN(0, dA0, dA1); if (c + 3 < 66) SSD_LOADDT(c + 3, dA0, dA1); }
                }
                f32x16 yacc = {}, sacc = {};
                if (outp) {
                    const float al = acum[32 * lb + r32];
                    for (int sb = 0; sb <= lb; ++sb) {
                        f32x16 accT = {};
#pragma unroll
                        for (int s = 0; s < 8; ++s) accT = __builtin_amdgcn_mfma_f32_32x32x16_bf16(rowfrag(BT, sb, s, lane), rowfrag(CT, lb, s, lane), accT, 0, 0, 0);
                        float val[16];
#pragma unroll
                        for (int qd = 0; qd < 4; ++qd) { const f32x4 as = *(LAS const f32x4*)(acum + 32 * sb + 8 * qd + 4 * hi);
#pragma unroll
                            for (int e = 0; e < 4; ++e) { const int sidx = 32 * sb + 8 * qd + 4 * hi + e, lidx = 32 * lb + r32; val[4 * qd + e] = (sidx <= lidx) ? accT[4 * qd + e] * __expf(al - as[e]) : 0.f; } }
                        bf16x8 ma0, ma1; PK4(val, 0, ma0); PK4(val, 8, ma1);
                        yacc = __builtin_amdgcn_mfma_f32_32x32x16_bf16(ma0, trfrag(X2, pb, 2 * sb, lane), yacc, 0, 0, 0);
                        yacc = __builtin_amdgcn_mfma_f32_32x32x16_bf16(ma1, trfrag(X2, pb, 2 * sb + 1, lane), yacc, 0, 0, 0);
                    }
#pragma unroll
                    for (int g4 = 0; g4 < 2; ++g4) {
                        bf16x8 cfr[4], hfr[4];
#pragma unroll
                        for (int s = 0; s < 4; ++s) { cfr[s] = rowfrag(CT, lb, 4 * g4 + s, lane); hfr[s] = rowfrag(HS, pb, 4 * g4 + s, lane); }
#pragma unroll
                        for (int s = 0; s < 4; ++s) sacc = __builtin_amdgcn_mfma_f32_32x32x16_bf16(cfr[s], hfr[s], sacc, 0, 0, 0);
                    }
                }
                {
                    const float etot = eac[127];
#pragma unroll
                    for (int r = 0; r < 16; ++r) hacc[r] *= etot;
#pragma unroll
                    for (int g4 = 0; g4 < 2; ++g4) {
                        bf16x8 af[4], xw[4];
#pragma unroll
                        for (int ks = 0; ks < 4; ++ks) { af[ks] = trfrag(BT, lb, 4 * g4 + ks, lane); xw[ks] = trfrag(X2, 2 + pb, 4 * g4 + ks, lane); }
#pragma unroll
                        for (int ks = 0; ks < 4; ++ks) hacc = __builtin_amdgcn_mfma_f32_32x32x16_bf16(af[ks], xw[ks], hacc, 0, 0, 0);
                    }
                }
                __syncthreads();
#pragma unroll
                for (int qd = 0; qd < 4; ++qd) { u32x2 w; w.x = cvt_pk_bf16(hacc[4 * qd], hacc[4 * qd + 1]); w.y = cvt_pk_bf16(hacc[4 * qd + 2], hacc[4 * qd + 3]);
                    *(LAS u32x2*)(HS + offb(32 * pb + r32, 4 * lb + qd) + 8 * hi) = w; }
                if (outp) {
#pragma unroll
                    for (int qd = 0; qd < 4; ++qd) { const f32x4 ea = *(LAS const f32x4*)(eac + 32 * lb + 8 * qd + 4 * hi);
#pragma unroll
                        for (int e = 0; e < 4; ++e) YST[(32 * lb + 8 * qd + 4 * hi + e) * 64 + 32 * pb + r32] = yacc[4 * qd + e] + ea[e] * sacc[4 * qd + e]; }
                }
                if (c + 1 < 66) SSD_TILES((c + 1) & 1);
                __syncthreads();
                if (c + 2 < 66) SSD_PREFETCH(c + 2);
                if (outp) {
#pragma unroll
                    for (int i = 0; i < 2; ++i) { const int v = tid + 512 * i, l = v >> 3, pv8 = v & 7;
                        const f32x4 y0 = *(LAS const f32x4*)(YST + l * 64 + 8 * pv8), y1 = *(LAS const f32x4*)(YST + l * 64 + 8 * pv8 + 4);
                        float y[8] = {y0.x, y0.y, y0.z, y0.w, y1.x, y1.y, y1.z, y1.w};
                        const int jrow = j0 + sgn * l;
                        bf16_t* yp = YS + ((size_t)b * SEQ + (jrow - CTXL)) * DIN + h * 64 + 8 * pv8;
                        if (dir) { float yf[8], xs[8]; unpack8(*(const u32x4*)yp, yf); unpack8(*(const u32x4*)(XBC + ((size_t)b * RPB + jrow) * CONVD + h * 64 + 8 * pv8), xs);
#pragma unroll
                            for (int e = 0; e < 8; ++e) y[e] += yf[e] + Dk * xs[e]; }
                        *(u32x4*)yp = pack8(y); }
                }
            }
            __syncthreads();
#undef SSD_J0
#undef SSD_PREFETCH
#undef SSD_SCAN
#undef SSD_LOADDT
#undef SSD_TILES
        }
    }
}

constexpr int PH_KIND0[24] = {0, 1, 2, 3, 4, 2, 1, 2, 2, 1, 2, 9, 2, 2, 1, 2, 2, 1, 99, 99, 99, 99, 99, 99};
constexpr int PH_ARG0[24]  = {0, 0, 0, 0, 0, 1, 1, 2, 3, 2, 4, 0, 5, 6, 3, 7, 8, 4, 0, 0, 0, 0, 0, 0};
#ifndef DUP_PH
#define DUP_PH -1
#endif
constexpr int ph_src(int i) { return (DUP_PH >= 0 && i > DUP_PH) ? i - 1 : i; }
#define NPH_RUN (18 + (DUP_PH >= 0 ? 1 : 0))
#ifndef PHMASK
#define PHMASK 0x3ff
#endif
#define EN(k) (((PHMASK) >> (k)) & 1)

template <int PH>
__device__ __forceinline__ void run_phase(cg::grid_group& grid, unsigned char* smem, const int wave_s) {
    if constexpr (PH < NPH_RUN) {
    constexpr int kind = PH_KIND0[ph_src(PH)], arg = PH_ARG0[ph_src(PH)];
    LAS unsigned char* lds = (LAS unsigned char*)smem;
    KP P = (KP)__builtin_amdgcn_kernarg_segment_ptr();
    asm volatile("" : "+s"(P));
    int G = gridDim.x; asm volatile("" : "+s"(G));
    int tidx_; asm volatile("v_mbcnt_lo_u32_b32 %0, -1, 0\n\tv_mbcnt_hi_u32_b32 %0, -1, %0" : "=v"(tidx_)); tidx_ += wave_s * 64;
    int bidx_ = __builtin_amdgcn_workgroup_id_x(); asm volatile("" : "+s"(bidx_));
    unsigned char* ws = P->ws;
    const float* NW = P->in[I_NORMW];
    bf16_t* YX = (bf16_t*)(ws + WS_YX);
    if constexpr (kind == 2 && EN(2)) {
        pg8::Gemm g; pg8::EpiMulti E; E.mode = 0; E.dt = nullptr; E.dtb = nullptr; E.rowss = (float*)(ws + WS_ROWSS); g.amap = 0; g.cmode = 0; E.halo = (bf16_t*)(ws + WS_HALO); E.halomode = 0; E.cw = nullptr; E.cbias = nullptr; E.rspace = 1; E.Mrows = 0;
        if constexpr (arg == 0) { g.A = YX; g.lda = 1024; g.Bt = (const bf16_t*)(ws + W_AIN); g.M = MR; g.N = INA; g.K = 1024; E.O = (bf16_t*)(ws + BIG_U); E.ldc = INA; }
        else if constexpr (arg == 1) { g.A = (const bf16_t*)(ws + BIG_MIX); g.lda = 1024; g.Bt = (const bf16_t*)(ws + W_AOUT); g.M = MR; g.N = 1024; g.K = 1024; E.O = YX; E.ldc = 1024; }
        else if constexpr (arg == 2) { g.A = YX; g.lda = 1024; g.Bt = (const bf16_t*)(ws + W_UP0); g.M = MR; g.N = DFF2; g.K = 1024; g.cmode = 1; E.mode = 4; E.O = (bf16_t*)(ws + BIG_H); E.ldc = DFF; E.cw = P->in[I_FCW]; E.cbias = P->in[I_FCB]; E.rspace = 1; E.Mrows = MR; }
        else if constexpr (arg == 3) { g.A = (const bf16_t*)(ws + BIG_H); g.lda = DFF; g.Bt = (const bf16_t*)(ws + W_DN0); g.M = MR; g.N = 1024; g.K = DFF; E.O = YX; E.ldc = 1024; }
        else if constexpr (arg == 4) { g.A = YX; g.lda = 1024; g.Bt = (const bf16_t*)(ws + W_SIN) + (size_t)DIN * 1024; g.M = MR; g.N = NXD; g.K = 1024; g.cmode = 2; E.mode = 5; E.O = (bf16_t*)(ws + BIG_XBC); E.ldc = CONVD;
                E.dt = (float*)(ws + BIG_DT); E.dtb = P->in[I_SDTB]; E.cw = P->in[I_SCW]; E.cbias = P->in[I_SCB]; E.rspace = 1; E.Mrows = MR; }
        else if constexpr (arg == 5) { g.A = YX; g.lda = 1024; g.amap = 1; g.Bt = (const bf16_t*)(ws + W_SIN); g.M = MT; g.N = DIN; g.K = 1024; E.mode = 2; E.O = (bf16_t*)(ws + BIG_YS); E.ldc = DIN; }
        else if constexpr (arg == 6) { g.A = (const bf16_t*)(ws + BIG_YS); g.lda = DIN; g.Bt = (const bf16_t*)(ws + W_SOUT); g.M = MT; g.N = 1024; g.K = DIN; E.mode = 3; E.O = (bf16_t*)(ws + BIG_YOUT); E.ldc = 1024; }
        else if constexpr (arg == 7) { g.A = YX; g.lda = 1024; g.Bt = (const bf16_t*)(ws + W_UP1); g.M = MT; g.N = DFF2; g.K = 1024; g.cmode = 1; E.mode = 4; E.O = (bf16_t*)(ws + BIG_H); E.ldc = DFF; E.cw = P->in[I_FCW] + (size_t)DFF2 * 3; E.cbias = P->in[I_FCB] + DFF2; E.rspace = 0; E.Mrows = MT; }
        else { g.A = (const bf16_t*)(ws + BIG_H); g.lda = DFF; g.Bt = (const bf16_t*)(ws + W_DN1); g.M = MT; g.N = 1024; g.K = DFF; E.O = YX; E.ldc = 1024; }
        pg8::StaticOrder S; S.init(g.cmode == 1 ? (g.M + 247) / 248 : g.cmode == 2 ? (g.M + 249) / 250 : g.M / pg8::BM, g.N, G, bidx_);
        pg8::gemm_phase<pg8::EpiMulti, pg8::StaticOrder>(lds, g, S, E, tidx_);
    } else if constexpr (kind == 1 && EN(1)) {
        RwDesc d; d.srcL = nullptr; d.srcC = nullptr; d.xsrc = nullptr; d.xdst = nullptr; d.odst = nullptr; d.Y = nullptr; d.nwA = nullptr; d.gate_k = 0; d.nwB = nullptr; d.shift_k = 0; d.scale_k = 0; d.XN = YX;
        bf16_t* XRES = (bf16_t*)(ws + WS_XRES);
        if constexpr (arg == 0) { d.rows = MR; d.rspace = 1; d.layer = 0; d.layerB = 0; d.srcL = P->in[I_X]; d.srcC = P->in[I_CTX]; d.nwB = NW + 0 * 1024; d.shift_k = 0; d.scale_k = 1; }
        else if constexpr (arg == 1) { d.rows = MR; d.rspace = 1; d.layer = 0; d.layerB = 0; d.srcL = P->in[I_X]; d.srcC = P->in[I_CTX]; d.xdst = XRES; d.Y = YX; d.nwA = NW + 1 * 1024; d.gate_k = 2; d.nwB = NW + 2 * 1024; d.shift_k = 3; d.scale_k = 4; }
        else if constexpr (arg == 2) { d.rows = MR; d.rspace = 1; d.layer = 0; d.layerB = 1; d.xsrc = XRES; d.xdst = XRES; d.Y = YX; d.nwA = NW + 3 * 1024; d.gate_k = 5; d.nwB = NW + 4 * 1024; d.shift_k = 0; d.scale_k = 1; }
        else if constexpr (arg == 3) { d.rows = MT; d.rspace = 0; d.layer = 1; d.layerB = 1; d.xsrc = XRES; d.xdst = XRES; d.Y = (const bf16_t*)(ws + BIG_YOUT); d.nwA = NW + 5 * 1024; d.gate_k = 2; d.nwB = NW + 6 * 1024; d.shift_k = 3; d.scale_k = 4; }
        else { d.rows = MT; d.rspace = 0; d.layer = 1; d.layerB = 1; d.xsrc = XRES; d.odst = P->out; d.Y = YX; d.nwA = NW + 7 * 1024; d.gate_k = 5; d.XN = nullptr; }
        phase_rw(P, d, G, tidx_, bidx_);
    } else if constexpr (kind == 0 && EN(0)) phase_p0(P, lds, G, tidx_, bidx_);
    else if constexpr (kind == 3 && EN(3)) phase_qkp(P, lds, G, tidx_, bidx_);
    else if constexpr (kind == 4 && EN(4)) phase_attn(P, (char*)smem, G, tidx_, bidx_);
    else if constexpr (kind == 5 && EN(5)) phase_halo_f(P, arg ? MT : MR, G, tidx_, bidx_);
    else if constexpr (kind == 6 && EN(6)) phase_cg(P, arg ? MT : MR, arg ? 0 : 1, arg, G, tidx_, bidx_);
    else if constexpr (kind == 7 && EN(7)) phase_halo_s(P, G, tidx_, bidx_);
    else if constexpr (kind == 8 && EN(8)) phase_conv_s(P, G, tidx_, bidx_);
    else if constexpr (kind == 9 && EN(9)) phase_ssd(P, lds, G, tidx_, bidx_);
    asm volatile("s_waitcnt vmcnt(0)" ::: "memory");
    __syncthreads();
    if (tidx_ == 0) {
        unsigned* bar = (unsigned*)(ws + WS_BAR);
        const unsigned xcc = (unsigned)__builtin_amdgcn_s_getreg((3 << 11) | 20) & 0xFu;
        const unsigned nloc = __hip_atomic_load(bar + 16 * (1 + xcc), __ATOMIC_RELAXED, __HIP_MEMORY_SCOPE_AGENT);
        unsigned nx = 0;
#pragma unroll
        for (int j = 0; j < 16; ++j) nx += __hip_atomic_load(bar + 16 * (1 + j), __ATOMIC_RELAXED, __HIP_MEMORY_SCOPE_AGENT) ? 1u : 0u;
        const unsigned old = __hip_atomic_fetch_add(bar + 16 * (17 + xcc), 1u, __ATOMIC_RELAXED, __HIP_MEMORY_SCOPE_AGENT);
        if (old + 1u == (unsigned)(PH + 1) * nloc) {
            __builtin_amdgcn_fence(__ATOMIC_RELEASE, "agent"); asm volatile("s_waitcnt vmcnt(0)" ::: "memory");
            __hip_atomic_fetch_add(bar, 1u, __ATOMIC_RELAXED, __HIP_MEMORY_SCOPE_AGENT);
            const unsigned want = (unsigned)(PH + 1) * nx;
            while (__hip_atomic_load(bar, __ATOMIC_RELAXED, __HIP_MEMORY_SCOPE_AGENT) < want) __builtin_amdgcn_s_sleep(1);
            __hip_atomic_fetch_add(bar + 16 * (33 + xcc), 1u, __ATOMIC_RELAXED, __HIP_MEMORY_SCOPE_AGENT);
        } else {
            while (__hip_atomic_load(bar + 16 * (33 + xcc), __ATOMIC_RELAXED, __HIP_MEMORY_SCOPE_AGENT) < (unsigned)(PH + 1)) __builtin_amdgcn_s_sleep(1);
        }
        __builtin_amdgcn_fence(__ATOMIC_ACQUIRE, "agent"); asm volatile("s_waitcnt vmcnt(0)" ::: "memory");
    }
    __syncthreads();
    }
}

__global__ void __launch_bounds__(512) mega(Params Pk) {
    extern __shared__ __attribute__((aligned(16))) unsigned char smem[];
    cg::grid_group grid = cg::this_grid();
    const int wave_s = __builtin_amdgcn_readfirstlane((int)__builtin_amdgcn_workitem_id_x() >> 6);
    if (threadIdx.x == 0) {
        const unsigned xcc = (unsigned)__builtin_amdgcn_s_getreg((3 << 11) | 20) & 0xFu;
        __hip_atomic_fetch_add((unsigned*)(Pk.ws + WS_BAR) + 16 * (1 + xcc), 1u, __ATOMIC_RELAXED, __HIP_MEMORY_SCOPE_AGENT);
    }
    grid.sync();
    run_phase<0>(grid, smem, wave_s);  run_phase<1>(grid, smem, wave_s);  run_phase<2>(grid, smem, wave_s);  run_phase<3>(grid, smem, wave_s);
    run_phase<4>(grid, smem, wave_s);  run_phase<5>(grid, smem, wave_s);  run_phase<6>(grid, smem, wave_s);  run_phase<7>(grid, smem, wave_s);
    run_phase<8>(grid, smem, wave_s);  run_phase<9>(grid, smem, wave_s);  run_phase<10>(grid, smem, wave_s); run_phase<11>(grid, smem, wave_s);
    run_phase<12>(grid, smem, wave_s); run_phase<13>(grid, smem, wave_s); run_phase<14>(grid, smem, wave_s); run_phase<15>(grid, smem, wave_s);
    run_phase<16>(grid, smem, wave_s); run_phase<17>(grid, smem, wave_s); run_phase<18>(grid, smem, wave_s); run_phase<19>(grid, smem, wave_s);
    run_phase<20>(grid, smem, wave_s); run_phase<21>(grid, smem, wave_s); run_phase<22>(grid, smem, wave_s); run_phase<23>(grid, smem, wave_s);
}

extern "C" void kernel_launch(void* const* d_in, const int* in_sizes, int n_in, void* d_out, int out_size, void* d_ws, size_t ws_size, hipStream_t stream) {
    static int grid_blocks = 0;
    if (grid_blocks == 0) {
        if (n_in != 25 || ws_size < WS_END) { fprintf(stderr, "kernel_launch: unexpected n_in %d or ws_size %zu (need %zu)\n", n_in, ws_size, (size_t)WS_END); grid_blocks = -1; return; }
        int dev = 0, cus = 0, per_cu = 0;
        hipGetDevice(&dev);
        hipDeviceGetAttribute(&cus, hipDeviceAttributeMultiprocessorCount, dev);
        if (hipFuncSetAttribute((const void*)mega, hipFuncAttributeMaxDynamicSharedMemorySize, LDS_BYTES) != hipSuccess) { fprintf(stderr, "kernel_launch: hipFuncSetAttribute failed\n"); grid_blocks = -1; return; }
        hipOccupancyMaxActiveBlocksPerMultiprocessor(&per_cu, (const void*)mega, 512, LDS_BYTES);
        if (per_cu < 1) { fprintf(stderr, "kernel_launch: occupancy query says %d blocks per CU\n", per_cu); per_cu = 1; }
        (void)hipGetLastError();
        grid_blocks = cus;
    }
    if (grid_blocks < 0) return;
    (void)hipMemsetAsync((char*)d_ws + WS_BAR, 0, 4096, stream);
    Params p{};
    for (int i = 0; i < 25; ++i) p.in[i] = (const float*)d_in[i];
    p.out = (float*)d_out; p.ws = (unsigned char*)d_ws;
    void* args[] = {&p};
    hipError_t e = hipLaunchCooperativeKernel((const void*)mega, dim3(grid_blocks), dim3(512), args, LDS_BYTES, stream);
    if (e != hipSuccess) fprintf(stderr, "cooperative launch failed: %s (grid %d)\n", hipGetErrorString(e), grid_blocks);
}
```

```cpp
#include <hip/hip_runtime.h>
#include <hip/hip_bf16.h>
#include <hip/hip_cooperative_groups.h>
#include <cstdio>
#include <cstdint>
namespace cg = cooperative_groups;

#define LAS __attribute__((address_space(3)))
typedef unsigned short bf16_t;
typedef short bf16x8 __attribute__((ext_vector_type(8)));
typedef short s16x4 __attribute__((ext_vector_type(4)));
typedef short v4i16_t __attribute__((ext_vector_type(4)));
typedef float f32x4 __attribute__((ext_vector_type(4)));
typedef float f32x16 __attribute__((ext_vector_type(16)));
typedef unsigned u32x4 __attribute__((ext_vector_type(4)));
typedef unsigned u32x2 __attribute__((ext_vector_type(2)));

constexpr int DM = 1024, NB = 8, SEQ = 8192, CTXL = 256, RPB = SEQ + CTXL, MR = NB * RPB, MT = NB * SEQ;
constexpr int INA = 1536, DFF = 2816, DFF2 = 5632, DIN = 2048, CONVD = 3072, NXD = 3328, SINP = 5376, INC = 5184;
constexpr float EPS = 1e-6f;
constexpr int LDS_BYTES = 154624;

constexpr size_t MiB = 1u << 20;
constexpr size_t WS_MOD = 0;
constexpr size_t WS_ROWSS = 512 * 1024;
constexpr size_t WS_BAR = 1024 * 1024 - 4096;
constexpr size_t WS_WB = 1 * MiB;
constexpr size_t W_AIN = WS_WB, W_AOUT = WS_WB + 3 * MiB, W_UP0 = WS_WB + 5 * MiB, W_DN0 = WS_WB + 16 * MiB;
constexpr size_t W_SIN = WS_WB + 22 * MiB, W_SOUT = WS_WB + 33 * MiB, W_UP1 = WS_WB + 37 * MiB, W_DN1 = WS_WB + 48 * MiB;
constexpr size_t WS_CX = 56 * MiB;
constexpr size_t WS_YX = 64 * MiB;
constexpr size_t WS_HALO = 196 * MiB;
constexpr size_t WS_BIG = 220 * MiB;
constexpr size_t WS_XRES = WS_BIG + 672 * MiB;
constexpr size_t WS_END = WS_XRES + 132 * MiB;
constexpr size_t BIG_U = WS_BIG, BIG_MIX = WS_BIG + 198 * MiB, BIG_UP = WS_BIG, BIG_H = WS_BIG;
constexpr size_t BIG_XBC = WS_BIG, BIG_DT = WS_BIG + 396 * MiB, BIG_YS = WS_BIG + 416 * MiB, BIG_YOUT = WS_BIG;

struct Params { const float* in[25]; float* out; unsigned char* ws; };
typedef const Params __attribute__((address_space(4)))* KP;
enum { I_X = 0, I_C, I_CTX, I_CCTX, I_ADAW, I_ADAB, I_NORMW, I_AWIN, I_POOLW, I_POOLS, I_QG, I_KG, I_AWOUT, I_SWIN, I_SCW, I_SCB, I_SALOG, I_SDTB, I_SD, I_SNW, I_SWOUT, I_FUP, I_FCW, I_FCB, I_FDN };

typedef float f32x2_t __attribute__((ext_vector_type(2))); typedef __bf16 bf16x2_t __attribute__((ext_vector_type(2)));
__device__ __forceinline__ unsigned cvt_pk_bf16(float lo, float hi) { f32x2_t v = {lo, hi}; bf16x2_t b = __builtin_convertvector(v, bf16x2_t); return __builtin_bit_cast(unsigned, b); }
__device__ __forceinline__ float bflo(unsigned w) { return __uint_as_float(w << 16); }
__device__ __forceinline__ float bfhi(unsigned w) { return __uint_as_float(w & 0xffff0000u); }
__device__ __forceinline__ void unpack8(const u32x4 q, float (&f)[8]) {
    f[0] = bflo(q.x); f[1] = bfhi(q.x); f[2] = bflo(q.y); f[3] = bfhi(q.y); f[4] = bflo(q.z); f[5] = bfhi(q.z); f[6] = bflo(q.w); f[7] = bfhi(q.w);
}
__device__ __forceinline__ u32x4 pack8(const float (&f)[8]) {
    u32x4 q; q.x = cvt_pk_bf16(f[0], f[1]); q.y = cvt_pk_bf16(f[2], f[3]); q.z = cvt_pk_bf16(f[4], f[5]); q.w = cvt_pk_bf16(f[6], f[7]); return q;
}
__device__ __forceinline__ float shx(float v, int mask, int lane) { return __int_as_float(__builtin_amdgcn_ds_bpermute(((lane ^ mask) & 63) << 2, __float_as_int(v))); }
__device__ __forceinline__ float shup(float v, int o, int lane) { return __int_as_float(__builtin_amdgcn_ds_bpermute(((lane - o) & 63) << 2, __float_as_int(v))); }
__device__ __forceinline__ float rdlane(float v, int i) { return __int_as_float(__builtin_amdgcn_readlane(__float_as_int(v), i)); }
__device__ __forceinline__ float wave_sum(float v, int lane) {
#pragma unroll
    for (int o = 1; o < 64; o <<= 1) v += shx(v, o, lane);
    return v;
}
__device__ __forceinline__ float siluf(float v) { return v * __builtin_amdgcn_rcpf(1.f + __expf(-v)); }

namespace pg8 {
constexpr int BM = 256, BK = 64, HALF = 128, HTB = HALF * BK * 2, STAGE_BYTES = 8 * HTB, NXCD = 8, WGM = 8;
__host__ __device__ __forceinline__ int lds_byte(int r, int c) { const int st = (r >> 4) * 2 + (c >> 5), rr = r & 15, cc = c & 31, ob = rr * 64 + cc * 2; return st * 1024 + (ob ^ (((ob >> 9) & 1) << 5)); }
__host__ __device__ __forceinline__ void stage_rc(int b, int& R, int& C) { const int st = b / 1024, sb = b % 1024, swz = sb ^ (((sb >> 9) & 1) << 5); R = (st >> 1) * 16 + swz / 64; C = (st & 1) * 32 + (swz % 64) / 2; }
__host__ __device__ __forceinline__ int perm32(int rho) { const int n = rho >> 4, i = rho & 15; return 8 * (i >> 2) + 4 * n + (i & 3); }

struct Unit { int pm, pn; };
struct Gemm { const bf16_t* A; const bf16_t* Bt; int M, N, K, lda, amap, cmode; };
__device__ __forceinline__ int tile_a(const Gemm& g, int pm) { return g.amap ? pm + (pm >> 5) + 1 : pm; }

struct StaticOrder {
    int nM, nN, nwg, G, c;
    __device__ void init(int nM_, int N, int G_, int c_) { nM = nM_; nN = N / BM; nwg = nM * nN; G = G_; c = c_; }
    __device__ bool next(int i, Unit& u) const {
        const long L = (long)i * G + c; if (L >= nwg) return false;
        int wgid = (int)L; { const int q = nwg / NXCD, r = nwg % NXCD, xcd = wgid % NXCD, off = wgid / NXCD; wgid = (xcd < r ? xcd * (q + 1) : r * (q + 1) + (xcd - r) * q) + off; }
        const int nig = WGM * nN, gid = wgid / nig, fm = gid * WGM, gsz = (nM - fm) < WGM ? (nM - fm) : WGM;
        u.pm = fm + ((wgid % nig) % gsz); u.pn = (wgid % nig) / gsz; return true;
    }
};

struct EpiMulti {
    static constexpr bool PERM = true;
    int mode;
    bf16_t* O; int ldc; float* dt; const float* dtb; float* rowss; bf16_t* halo; int halomode; const float* cw; const float* cbias; int rspace, Mrows;
    __device__ __forceinline__ void row_op(f32x4 a00, f32x4 a01, f32x4 a10, f32x4 a11, const int r, const int col0, const int pn, const int fq) const {
        float ss = 0.f, rs = 1.f;
        if (mode == 3) rs = rsqrtf(rowss[r] * (1.f / 2048.f) + EPS);
#pragma unroll
        for (int bj = 0; bj < 2; ++bj) {
            f32x4 v0 = bj ? a10 : a00, v1 = bj ? a11 : a01;
            const int c = col0 + bj * HALF;
            if (mode == 1 && pn == 12) {
                const int cc = c - CONVD;
                if (cc < 64) {
                    const f32x4 b0 = *(const f32x4*)(dtb + cc), b1 = *(const f32x4*)(dtb + cc + 4);
                    f32x4 o0, o1;
#pragma unroll
                    for (int e = 0; e < 4; ++e) { const float a = v0[e] + b0[e], b = v1[e] + b1[e]; o0[e] = a > 20.f ? a : __logf(1.f + __expf(a)); o1[e] = b > 20.f ? b : __logf(1.f + __expf(b)); }
                    *(f32x4*)(dt + (size_t)r * 64 + cc) = o0; *(f32x4*)(dt + (size_t)r * 64 + cc + 4) = o1;
                }
            } else {
                bf16_t* op = O + (size_t)r * ldc + c;
                if (mode == 2) {
                    const u32x4 yq = *(const u32x4*)op; float y[8]; unpack8(yq, y);
#pragma unroll
                    for (int e = 0; e < 4; ++e) { v0[e] = y[e] * siluf(v0[e]); v1[e] = y[4 + e] * siluf(v1[e]); ss += v0[e] * v0[e] + v1[e] * v1[e]; }
                }
                if (mode == 3) { v0 = v0 * rs; v1 = v1 * rs; }
                u32x4 w; w.x = cvt_pk_bf16(v0[0], v0[1]); w.y = cvt_pk_bf16(v0[2], v0[3]); w.z = cvt_pk_bf16(v1[0], v1[1]); w.w = cvt_pk_bf16(v1[2], v1[3]);
                *(u32x4*)op = w;
                if (halomode) {
                    const int r64 = r & 63;
                    if (halomode == 1) { if (r64 == 0 || r64 == 63) *(u32x4*)(halo + ((size_t)(r >> 6) * 2 + (r64 ? 1 : 0)) * ldc + c) = w; }
                    else { if (r64 == 0 || r64 >= 62) *(u32x4*)(halo + ((size_t)(r >> 6) * 3 + (r64 ? r64 - 61 : 0)) * ldc + c) = w; }
                }
            }
        }
        if (mode == 2) { const int ln = (r & 15) | (fq << 4); ss += shx(ss, 16, ln); ss += shx(ss, 32, ln); if (fq == 0) atomicAdd(rowss + r, ss); }
    }
    __device__ __forceinline__ void conv_epi(const f32x4 (&acc)[2][2][4][2], const Unit& u, int wr, int wc, int fr, int fq) const {
        const int lane = fr | (fq << 4);
        const int tokb = 248 * u.pm - 1 + 62 * wr + 4 * fr;
        const int colh = 128 * u.pn + 32 * wc + 8 * fq;
        unsigned fvalid = 0u, fstart = 0u, fend = 0u;
#pragma unroll
        for (int q = 0; q < 8; ++q) { const int m = q & 3, tok = tokb + 124 * (q >> 2) + m;
            const bool valid = !(fr == 0 && m == 0) && !(fr == 15 && m == 3) && tok >= 0 && tok < Mrows;
            bool sstart, send;
            if (rspace) { const int j = tok % RPB; sstart = (j == 0) || (j == CTXL); send = (j == CTXL - 1) || (j == RPB - 1); }
            else { const int j = tok & (SEQ - 1); sstart = (j == 0); send = (j == SEQ - 1); }
            fvalid |= (valid ? 1u : 0u) << q; fstart |= (sstart ? 1u : 0u) << q; fend |= (send ? 1u : 0u) << q; }
#pragma unroll
        for (int n = 0; n < 2; ++n) {
            float wv[4][3], wg[4][3], bv[4], bg[4];
#pragma unroll
            for (int e = 0; e < 4; ++e) { const int c = colh + 4 * n + e;
#pragma unroll
                for (int k = 0; k < 3; ++k) { wv[e][k] = cw[c * 3 + k]; wg[e][k] = cw[(DFF + c) * 3 + k]; }
                bv[e] = cbias[c]; bg[e] = cbias[DFF + c]; }
#pragma unroll
            for (int ai = 0; ai < 2; ++ai) {
                f32x4 pv, pg, nv, ng;
#pragma unroll
                for (int e = 0; e < 4; ++e) { pv[e] = shx(acc[ai][0][3][n][e], 0, lane - 1); pg[e] = shx(acc[ai][1][3][n][e], 0, lane - 1);
                    nv[e] = shx(acc[ai][0][0][n][e], 0, lane + 1); ng[e] = shx(acc[ai][1][0][n][e], 0, lane + 1); }
#pragma unroll
                for (int m = 0; m < 4; ++m) {
                    const int q = 4 * ai + m, tok = tokb + 124 * ai + m;
                    const bool valid = (fvalid >> q) & 1u, sstart = (fstart >> q) & 1u, send = (fend >> q) & 1u;
                    const f32x4 uv = acc[ai][0][m][n], ug = acc[ai][1][m][n];
                    const f32x4 qv = (m == 0) ? pv : acc[ai][0][m > 0 ? m - 1 : 0][n], qg = (m == 0) ? pg : acc[ai][1][m > 0 ? m - 1 : 0][n];
                    const f32x4 rv = (m == 3) ? nv : acc[ai][0][m < 3 ? m + 1 : 3][n], rg = (m == 3) ? ng : acc[ai][1][m < 3 ? m + 1 : 3][n];
                    float h[4];
#pragma unroll
                    for (int e = 0; e < 4; ++e) {
                        float val = bv[e] + wv[e][1] * uv[e], gt = bg[e] + wg[e][1] * ug[e];
                        val += sstart ? 0.f : wv[e][0] * qv[e]; gt += sstart ? 0.f : wg[e][0] * qg[e];
                        val += send ? 0.f : wv[e][2] * rv[e]; gt += send ? 0.f : wg[e][2] * rg[e];
                        h[e] = siluf(gt) * val; }
                    if (valid) { u32x2 w; w.x = cvt_pk_bf16(h[0], h[1]); w.y = cvt_pk_bf16(h[2], h[3]); *(u32x2*)(O + (size_t)tok * ldc + colh + 4 * n) = w; }
                }
            }
        }
    }
    __device__ __forceinline__ void convs_epi(const f32x4 (&acc)[2][2][4][2], const Unit& u, int wr, int wc, int fr, int fq) const {
        const int lane = fr | (fq << 4);
        const int tokb = 250 * u.pm - 2 + 125 * wr + 8 * fr;
        if (u.pn == 12) {
            const int cc = 32 * wc + 8 * fq;
            if (cc < 64) {
#pragma unroll
                for (int q = 0; q < 8; ++q) { const int tb = 8 * fr + q, tok = tokb + q;
                    if (tb >= 2 && tb <= 126 && tok >= 0 && tok < Mrows) {
#pragma unroll
                        for (int n = 0; n < 2; ++n) { const f32x4 v = acc[q >> 2][0][q & 3][n]; const f32x4 b4 = *(const f32x4*)(dtb + cc + 4 * n); f32x4 o;
#pragma unroll
                            for (int e = 0; e < 4; ++e) { const float a = v[e] + b4[e]; o[e] = a > 20.f ? a : __logf(1.f + __expf(a)); }
                            *(f32x4*)(dt + (size_t)tok * 64 + cc + 4 * n) = o; } } }
            }
            return;
        }
        unsigned fvalid = 0u, fs0 = 0u, fs1 = 0u, fse = 0u;
#pragma unroll
        for (int q = 0; q < 8; ++q) { const int tb = 8 * fr + q, tok = tokb + q; const int j = tok % RPB;
            fvalid |= ((tb >= 2 && tb <= 126 && tok >= 0 && tok < Mrows) ? 1u : 0u) << q;
            fs0 |= (((j == 0) || (j == CTXL)) ? 1u : 0u) << q; fs1 |= (((j == 1) || (j == CTXL + 1)) ? 1u : 0u) << q; fse |= (((j == CTXL - 1) || (j == RPB - 1)) ? 1u : 0u) << q; }
#pragma unroll
        for (int bj = 0; bj < 2; ++bj)
#pragma unroll
            for (int n = 0; n < 2; ++n) {
                const int c0 = u.pn * BM + bj * HALF + wc * 32 + 8 * fq + 4 * n;
                float w[4][4], bb[4];
#pragma unroll
                for (int e = 0; e < 4; ++e) { const f32x4 q4 = *(const f32x4*)(cw + (size_t)(c0 + e) * 4); w[e][0] = q4.x; w[e][1] = q4.y; w[e][2] = q4.z; w[e][3] = q4.w; bb[e] = cbias[c0 + e]; }
                f32x4 p2, p3, nx;
#pragma unroll
                for (int e = 0; e < 4; ++e) { p2[e] = shx(acc[1][bj][2][n][e], 0, lane - 1); p3[e] = shx(acc[1][bj][3][n][e], 0, lane - 1); nx[e] = shx(acc[0][bj][0][n][e], 0, lane + 1); }
#pragma unroll
                for (int q = 0; q < 8; ++q) {
                    const int tok = tokb + q;
                    const bool valid = (fvalid >> q) & 1u, s0 = (fs0 >> q) & 1u, s1 = (fs1 >> q) & 1u, se = (fse >> q) & 1u;
                    const f32x4 u0 = acc[q >> 2][bj][q & 3][n];
                    const f32x4 um2 = q >= 2 ? acc[(q >= 2 ? q - 2 : 0) >> 2][bj][(q >= 2 ? q - 2 : 0) & 3][n] : (q == 0 ? p2 : p3);
                    const f32x4 um1 = q >= 1 ? acc[(q >= 1 ? q - 1 : 0) >> 2][bj][(q >= 1 ? q - 1 : 0) & 3][n] : p3;
                    const f32x4 up1 = q <= 6 ? acc[(q <= 6 ? q + 1 : 7) >> 2][bj][(q <= 6 ? q + 1 : 7) & 3][n] : nx;
                    float o[4];
#pragma unroll
                    for (int e = 0; e < 4; ++e) { float a = bb[e] + w[e][2] * u0[e];
                        a += (s0 || s1) ? 0.f : w[e][0] * um2[e]; a += s0 ? 0.f : w[e][1] * um1[e]; a += se ? 0.f : w[e][3] * up1[e]; o[e] = siluf(a); }
                    if (valid) { u32x2 pk; pk.x = cvt_pk_bf16(o[0], o[1]); pk.y = cvt_pk_bf16(o[2], o[3]); *(u32x2*)(O + (size_t)tok * ldc + c0) = pk; }
                }
            }
    }
    __device__ __forceinline__ void operator()(const f32x4 (&acc)[2][2][4][2], const Unit& u, int wr, int wc, int fr, int fq) const {
        if (mode == 4) { conv_epi(acc, u, wr, wc, fr, fq); return; }
        if (mode == 5) { convs_epi(acc, u, wr, wc, fr, fq); return; }
        const int row0 = u.pm * BM + wr * 64 + fr, col0 = u.pn * BM + wc * 32 + 8 * fq;
#define EPI_ROW(ai, m) row_op(acc[ai][0][m][0], acc[ai][0][m][1], acc[ai][1][m][0], acc[ai][1][m][1], row0 + (ai) * HALF + (m) * 16, col0, u.pn, fq)
        EPI_ROW(0, 0); EPI_ROW(0, 1); EPI_ROW(0, 2); EPI_ROW(0, 3); EPI_ROW(1, 0); EPI_ROW(1, 1); EPI_ROW(1, 2); EPI_ROW(1, 3);
#undef EPI_ROW
    }
};

template <class Epi, class Sched>
__device__ __forceinline__ void gemm_phase(LAS unsigned char* lds, const Gemm g, const Sched& S, const Epi& E, const int tidx_) {
    const int tid = tidx_, wid = __builtin_amdgcn_readfirstlane(tid >> 6), lane = tid & 63, wr = wid >> 2, wc = wid & 3, fr = lane & 15, fq = lane >> 4;
    const int K = g.K, nt = K / BK, lda = g.lda;
    unsigned voffA[2], voffB[2];
#pragma unroll
    for (int i = 0; i < 2; ++i) { int R, C; stage_rc(tid * 16 + i * 8192, R, C); const int Rb = Epi::PERM ? ((R & ~31) + perm32(R & 31)) : R;
        const int Ra = g.cmode == 1 ? 62 * (R >> 6) + 4 * (R & 15) + ((R >> 4) & 3)
                     : g.cmode == 2 ? 125 * (R >> 6) + 8 * (R & 15) + ((R >> 4) & 3) : R;
        voffA[i] = (unsigned)(Ra * lda + C) * 2u; voffB[i] = (unsigned)(Rb * K + C) * 2u; }
    const size_t kstep = (size_t)(BK * 2);
    const size_t hstepA = (size_t)(g.cmode == 1 ? 124 : g.cmode == 2 ? 4 : HALF) * lda * 2, hstepB = (size_t)HALF * K * 2;
    const char* Abase = (const char*)g.A - (size_t)g.cmode * lda * 2;
    const size_t tstepA = (size_t)(g.cmode == 1 ? 248 : g.cmode == 2 ? 250 : BM) * lda * 2, tstepB = 2 * hstepB;
    const unsigned ldsw = (unsigned)wid * 1024u;
    const int aoff = lds_byte(wr * 64 + fr, fq * 8), boff = lds_byte(wc * 32 + fr, fq * 8);
#define PG8_SA(b, h) (((b) * 2 + (h)) * HTB)
#define PG8_SB(b, h) ((4 + (b) * 2 + (h)) * HTB)
#define PG8_STAGE(bufoff, gbase, voff) do { _Pragma("unroll") for (int _i = 0; _i < 2; ++_i) \
        __builtin_amdgcn_global_load_lds((const unsigned*)((const char*)(gbase) + (voff)[_i]), (LAS unsigned*)(lds + (bufoff) + ldsw + _i * 8192), 16, 0, 0); } while (0)
#define PG8_LDA(dst, b, h) do { _Pragma("unroll") for (int m = 0; m < 4; ++m) _Pragma("unroll") for (int k = 0; k < 2; ++k) dst[m][k] = *(const LAS bf16x8*)(lds + PG8_SA(b, h) + aoff + m * 2048 + k * 1024); } while (0)
#define PG8_LDB(dst, b, h) do { _Pragma("unroll") for (int n = 0; n < 2; ++n) _Pragma("unroll") for (int k = 0; k < 2; ++k) dst[n][k] = *(const LAS bf16x8*)(lds + PG8_SB(b, h) + boff + n * 2048 + k * 1024); } while (0)
#define PG8_MMA(ai, bj, At, Bt) do { __builtin_amdgcn_s_setprio(1); _Pragma("unroll") for (int m = 0; m < 4; ++m) _Pragma("unroll") for (int n = 0; n < 2; ++n) _Pragma("unroll") for (int k = 0; k < 2; ++k) \
        acc[ai][bj][m][n] = __builtin_amdgcn_mfma_f32_16x16x32_bf16(Bt[n][k], At[m][k], acc[ai][bj][m][n], 0, 0, 0); __builtin_amdgcn_s_setprio(0); } while (0)
#define PG8_WAIT_V(n) asm volatile("s_waitcnt vmcnt(" #n ")" ::: "memory")
#define PG8_WAIT_L(n) asm volatile("s_waitcnt lgkmcnt(" #n ")" ::: "memory")
#define PG8_BAR __builtin_amdgcn_s_barrier()
#define PG8_SCHED __builtin_amdgcn_sched_barrier(0)
    Unit cur, nxt; int ui = 0;
    if (!S.next(0, cur)) return;
    f32x4 acc[2][2][4][2];
#pragma unroll
    for (int a = 0; a < 2; ++a)
#pragma unroll
        for (int b = 0; b < 2; ++b)
#pragma unroll
            for (int m = 0; m < 4; ++m)
#pragma unroll
                for (int n = 0; n < 2; ++n) acc[a][b][m][n] = (f32x4){0.f, 0.f, 0.f, 0.f};
    bf16x8 At[4][2], B0[2][2], B1[2][2];
    const char* cA = Abase + (size_t)tile_a(g, cur.pm) * tstepA; const char* cB = (const char*)g.Bt + (size_t)cur.pn * tstepB;
    PG8_STAGE(PG8_SB(0, 0), cB, voffB); PG8_STAGE(PG8_SB(0, 1), cB + hstepB, voffB); PG8_STAGE(PG8_SA(0, 0), cA, voffA); PG8_STAGE(PG8_SA(0, 1), cA + hstepA, voffA);
    if (wr == 1) PG8_BAR;
    PG8_WAIT_V(2); PG8_BAR;
    PG8_STAGE(PG8_SB(1, 0), cB + kstep, voffB); PG8_STAGE(PG8_SA(1, 0), cA + kstep, voffA); PG8_STAGE(PG8_SB(1, 1), cB + hstepB + kstep, voffB);
    PG8_WAIT_V(6); PG8_BAR;
    for (;;) {
        const bool has_next = S.next(ui + 1, nxt);
        const char* nA = has_next ? Abase + (size_t)tile_a(g, nxt.pm) * tstepA : cA; const char* nB = has_next ? (const char*)g.Bt + (size_t)nxt.pn * tstepB : cB;
        for (int t = 0; t < nt; t += 2) {
            const bool last = (t == nt - 2);
            const char* a1 = cA + (size_t)(t + 1) * kstep;
            const char* a2 = last ? nA : cA + (size_t)(t + 2) * kstep; const char* b2 = last ? nB : cB + (size_t)(t + 2) * kstep;
            const char* a3 = a2 + kstep; const char* b3 = b2 + kstep;
            PG8_LDB(B0, 0, 0); PG8_LDB(B1, 0, 1); PG8_SCHED; PG8_LDA(At, 0, 0); PG8_STAGE(PG8_SA(1, 1), a1 + hstepA, voffA);
            PG8_WAIT_V(8); PG8_WAIT_L(0); PG8_BAR; PG8_MMA(0, 0, At, B0); PG8_MMA(0, 1, At, B1); PG8_BAR; PG8_SCHED;
            PG8_LDA(At, 0, 1); PG8_STAGE(PG8_SB(0, 0), b2, voffB); PG8_STAGE(PG8_SB(0, 1), b2 + hstepB, voffB); PG8_STAGE(PG8_SA(0, 0), a2, voffA);
            PG8_WAIT_V(8); PG8_WAIT_L(0); PG8_BAR; PG8_MMA(1, 0, At, B0); PG8_MMA(1, 1, At, B1); PG8_BAR; PG8_SCHED;
            PG8_LDB(B0, 1, 0); PG8_LDB(B1, 1, 1); PG8_SCHED; PG8_LDA(At, 1, 0); PG8_STAGE(PG8_SA(0, 1), a2 + hstepA, voffA);
            PG8_WAIT_V(8); PG8_WAIT_L(0); PG8_BAR; PG8_MMA(0, 0, At, B0); PG8_MMA(0, 1, At, B1); PG8_BAR; PG8_SCHED;
            PG8_LDA(At, 1, 1); PG8_STAGE(PG8_SB(1, 0), b3, voffB); PG8_STAGE(PG8_SB(1, 1), b3 + hstepB, voffB); PG8_STAGE(PG8_SA(1, 0), a3, voffA);
            PG8_WAIT_V(8); PG8_WAIT_L(0); PG8_BAR; PG8_MMA(1, 0, At, B0); PG8_MMA(1, 1, At, B1); PG8_BAR; PG8_SCHED;
        }
        if (wr == 0) PG8_BAR;
        E(acc, cur, wr, wc, fr, fq);
        if (!has_next) break;
#pragma unroll
        for (int a = 0; a < 2; ++a)
#pragma unroll
            for (int b = 0; b < 2; ++b)
#pragma unroll
                for (int m = 0; m < 4; ++m)
#pragma unroll
                    for (int n = 0; n < 2; ++n) acc[a][b][m][n] = (f32x4){0.f, 0.f, 0.f, 0.f};
        cur = nxt; cA = nA; cB = nB; ++ui;
        if (wr == 1) PG8_BAR;
    }
    PG8_WAIT_V(0);
    PG8_BAR;
#undef PG8_SA
#undef PG8_SB
#undef PG8_STAGE
#undef PG8_LDA
#undef PG8_LDB
#undef PG8_MMA
#undef PG8_WAIT_V
#undef PG8_WAIT_L
#undef PG8_BAR
#undef PG8_SCHED
}
}

namespace att {
constexpr int D = 128, NW = 8, QBLK = 32, KVBLK = 64;
constexpr float SCALE = 0.088388347648318440f;
constexpr float THR = 8.f;
constexpr int LDQ = INA, LDK = INA, LDO = DM;
constexpr size_t SHM_V = KVBLK * D * 2, SHM_K = KVBLK * D * 2;
#define KSWZ(row, colB) ((row) * 256 + ((colB) ^ (((row) & 7) << 4)))
#define SBAR() __builtin_amdgcn_sched_barrier(0)
__device__ __forceinline__ int crow(int r, int hi) { return (r & 3) + 8 * (r >> 2) + 4 * hi; }
__device__ __forceinline__ void partialSM(f32x16& p0, f32x16& p1, float& m_reg, float& mn, float& alpha) {
    constexpr float C = SCALE * 1.4426950408889634f;
    float pmax = p0[0];
#pragma unroll
    for (int r = 1; r < 16; ++r) pmax = fmaxf(pmax, p0[r]);
#pragma unroll
    for (int r = 0; r < 16; ++r) pmax = fmaxf(pmax, p1[r]);
    { auto rr = __builtin_amdgcn_permlane32_swap(__float_as_uint(pmax), __float_as_uint(pmax), false, false);
      pmax = fmaxf(__uint_as_float(rr[0]), __uint_as_float(rr[1])); }
    if (__builtin_expect(__all(pmax - m_reg <= THR / SCALE), 1)) { mn = m_reg; alpha = 1.f; }
    else { mn = fmaxf(m_reg, pmax); alpha = __builtin_amdgcn_exp2f((m_reg - mn) * C); m_reg = mn; }
    float mnC = -mn * C;
#pragma unroll
    for (int r = 0; r < 16; ++r) p0[r] = fmaf(p0[r], C, mnC);
#pragma unroll
    for (int r = 0; r < 16; ++r) p1[r] = fmaf(p1[r], C, mnC);
#pragma unroll
    for (int r = 0; r < 16; ++r) p0[r] = __builtin_amdgcn_exp2f(p0[r]);
}
#define PK4(P, BASE, OUT) do { unsigned a0 = cvt_pk_bf16(P[BASE + 0], P[BASE + 1]), a1 = cvt_pk_bf16(P[BASE + 2], P[BASE + 3]);   \
    unsigned b0 = cvt_pk_bf16(P[BASE + 4], P[BASE + 5]), b1 = cvt_pk_bf16(P[BASE + 6], P[BASE + 7]);                              \
    auto r0 = __builtin_amdgcn_permlane32_swap(a0, b0, false, false); auto r1 = __builtin_amdgcn_permlane32_swap(a1, b1, false, false); \
    u32x4 w = {r0[0], r1[0], r0[1], r1[1]}; OUT = *reinterpret_cast<bf16x8*>(&w); } while (0)
__device__ __forceinline__ void finishSM(f32x16& p0, f32x16& p1, float alpha, float& l_reg, bf16x8& pa0, bf16x8& pa1, bf16x8& pa2, bf16x8& pa3) {
#pragma unroll
    for (int r = 0; r < 16; ++r) p1[r] = __builtin_amdgcn_exp2f(p1[r]);
    float ps = 0;
#pragma unroll
    for (int r = 0; r < 16; ++r) ps += p0[r];
#pragma unroll
    for (int r = 0; r < 16; ++r) ps += p1[r];
    { auto rr = __builtin_amdgcn_permlane32_swap(__float_as_uint(ps), __float_as_uint(ps), false, false);
      ps = __uint_as_float(rr[0]) + __uint_as_float(rr[1]); }
    l_reg = l_reg * alpha + ps;
    PK4(p0, 0, pa0); PK4(p0, 8, pa1); PK4(p1, 0, pa2); PK4(p1, 8, pa3);
}
__device__ __forceinline__ void qkt(f32x16& p0, f32x16& p1, const bf16_t* Ks, const bf16x8* qr, int r32, int hi) {
    p0 = f32x16{}; p1 = f32x16{};
#pragma unroll
    for (int d0 = 0; d0 < 8; ++d0) { int cb = (d0 * 16 + hi * 8) * 2;
        bf16x8 b0 = *reinterpret_cast<const bf16x8*>((const char*)Ks + KSWZ(r32, cb));
        bf16x8 b1 = *reinterpret_cast<const bf16x8*>((const char*)Ks + KSWZ(32 + r32, cb));
        p0 = __builtin_amdgcn_mfma_f32_32x32x16_bf16(b0, qr[d0], p0, 0, 0, 0);
        p1 = __builtin_amdgcn_mfma_f32_32x32x16_bf16(b1, qr[d0], p1, 0, 0, 0); }
}
__device__ __forceinline__ int v_st(int k, int c) { const int kk = (k & ~0xC) | ((k & 4) << 1) | ((k & 8) >> 1); return ((kk >> 3) * 4 + (c >> 5)) * 512 + ((kk & 7) * 32 + (c & 31)) * 2; }
__device__ __forceinline__ int v_rd_base(int lane) { return ((lane & 3) << 3) | (((lane >> 2) & 3) << 6) | (((lane >> 4) & 1) << 5) | (((lane >> 5) & 1) << 8); }
constexpr int v_rd_off(int d0, int ks, int half) { return d0 * 512 + ks * 4096 + half * 2048; }
template <int OFF> __device__ __forceinline__ s16x4 tr_read(int vb) {
    s16x4 r; asm volatile("ds_read_b64_tr_b16 %0, %1 offset:%2" : "=&v"(r) : "v"(vb), "i"(OFF) : "memory"); return r;
}
template <int D0> __device__ __forceinline__ void pv_one(f32x16& od, int vb, bf16x8 pa0, bf16x8 pa1, bf16x8 pa2, bf16x8 pa3) {
    const s16x4 l0 = tr_read<v_rd_off(D0, 0, 0)>(vb), h0 = tr_read<v_rd_off(D0, 0, 1)>(vb), l1 = tr_read<v_rd_off(D0, 1, 0)>(vb), h1 = tr_read<v_rd_off(D0, 1, 1)>(vb);
    const s16x4 l2 = tr_read<v_rd_off(D0, 2, 0)>(vb), h2 = tr_read<v_rd_off(D0, 2, 1)>(vb), l3 = tr_read<v_rd_off(D0, 3, 0)>(vb), h3 = tr_read<v_rd_off(D0, 3, 1)>(vb);
    asm volatile("s_waitcnt lgkmcnt(0)" ::: "memory"); SBAR();
#define PKV(L, H) (bf16x8){L[0], L[1], L[2], L[3], H[0], H[1], H[2], H[3]}
    od = __builtin_amdgcn_mfma_f32_32x32x16_bf16(pa0, PKV(l0, h0), od, 0, 0, 0);
    od = __builtin_amdgcn_mfma_f32_32x32x16_bf16(pa1, PKV(l1, h1), od, 0, 0, 0);
    od = __builtin_amdgcn_mfma_f32_32x32x16_bf16(pa2, PKV(l2, h2), od, 0, 0, 0);
    od = __builtin_amdgcn_mfma_f32_32x32x16_bf16(pa3, PKV(l3, h3), od, 0, 0, 0);
#undef PKV
}
__device__ __forceinline__ void pv_d0(f32x16* o, int vb, bf16x8 pa0, bf16x8 pa1, bf16x8 pa2, bf16x8 pa3) {
    pv_one<0>(o[0], vb, pa0, pa1, pa2, pa3); pv_one<1>(o[1], vb, pa0, pa1, pa2, pa3); pv_one<2>(o[2], vb, pa0, pa1, pa2, pa3); pv_one<3>(o[3], vb, pa0, pa1, pa2, pa3);
}

__device__ __forceinline__ void attn_dense_body(const bf16_t* __restrict__ Qb, const bf16_t* __restrict__ Kh, const bf16_t* __restrict__ Vh,
                                                bf16_t* __restrict__ Ob, int seq, char* lds, const int tidx_) {
    const int tid = tidx_, wid = tid >> 6, lane = tid & 63, r32 = lane & 31, hi = lane >> 5;
    bf16_t* V_lds = (bf16_t*)lds; bf16_t* K_lds = (bf16_t*)(lds + 2 * SHM_V);
    float* ws = (float*)(lds + 2 * SHM_V + 2 * SHM_K) + wid * 64; float* li_l = ws; float* al_l = ws + 32;
    float m_reg = -1e30f, l_reg = 0; f32x16 o[4] = {}; bf16x8 qr[8];
    const bf16_t* Qw = Qb + (long)(wid * QBLK + r32) * LDQ + hi * 8;
#pragma unroll
    for (int d0 = 0; d0 < 8; ++d0) qr[d0] = *reinterpret_cast<const bf16x8*>(Qw + d0 * 16);
    const int sr = tid >> 4, sc = (tid & 15) * 8, vst0 = v_st(sr, sc), vst1 = v_st(32 + sr, sc);
    const int vb0 = (int)(uintptr_t)V_lds + v_rd_base(lane);
    struct { bf16x8 vs0, vs1, ks0, ks1; } sr_[2];
    const unsigned rowoff = (unsigned)(sr * LDK + sc) * 2u;
#define SLOAD(i, k0) do { const unsigned o_ = rowoff + (unsigned)(k0) * (unsigned)(LDK * 2); \
    sr_[i].vs0 = *reinterpret_cast<const bf16x8*>((const char*)Vh + o_); sr_[i].vs1 = *reinterpret_cast<const bf16x8*>((const char*)Vh + o_ + 32u * LDK * 2u); \
    sr_[i].ks0 = *reinterpret_cast<const bf16x8*>((const char*)Kh + o_); sr_[i].ks1 = *reinterpret_cast<const bf16x8*>((const char*)Kh + o_ + 32u * LDK * 2u); } while (0)
#define SWRITE(b, i) do { *(bf16x8*)((char*)V_lds + (b) * SHM_V + vst0) = sr_[i].vs0;          \
    *(bf16x8*)((char*)V_lds + (b) * SHM_V + vst1) = sr_[i].vs1; int kc = sc * 2;               \
    *(bf16x8*)((char*)K_lds + (b) * SHM_K + KSWZ(sr, kc)) = sr_[i].ks0;                       \
    *(bf16x8*)((char*)K_lds + (b) * SHM_K + KSWZ(32 + sr, kc)) = sr_[i].ks1; } while (0)
#define SWAIT() asm volatile("s_waitcnt vmcnt(4)" ::: "memory")
#define RESC(a) do { if (__any((a) < 1.f)) { if (hi == 0) al_l[r32] = (a); asm volatile("s_waitcnt lgkmcnt(0)" ::: "memory"); \
    _Pragma("unroll") for (int d = 0; d < 4; ++d) _Pragma("unroll") for (int r = 0; r < 16; ++r) o[d][r] *= al_l[crow(r, hi)]; } } while (0)
    f32x16 pA0, pA1, pB0, pB1; float mnA, mnB, alA, alB; bf16x8 pa0, pa1, pa2, pa3; const int NT = seq / KVBLK;
    constexpr int SE = 0, SO = 1;
    SLOAD(SE, 0); asm volatile("s_waitcnt vmcnt(0)" ::: "memory"); SWRITE(0, SE); __syncthreads();
    qkt(pA0, pA1, K_lds, qr, r32, hi); partialSM(pA0, pA1, m_reg, mnA, alA);
    SLOAD(SO, KVBLK); if (2 < NT) SLOAD(SE, 2 * KVBLK);
    SWAIT(); SWRITE(1, SO); __syncthreads();
    for (int j = 1; j + 1 < NT; j += 2) {
        SBAR(); qkt(pB0, pB1, (bf16_t*)((char*)K_lds + SHM_K), qr, r32, hi);
        finishSM(pA0, pA1, alA, l_reg, pa0, pa1, pa2, pa3); SBAR();
        SLOAD(SO, (j + 2) * KVBLK); SBAR();
        pv_d0(o, vb0, pa0, pa1, pa2, pa3); partialSM(pB0, pB1, m_reg, mnB, alB);
        __syncthreads(); SWAIT(); SWRITE(0, SE);
        RESC(alB); __syncthreads();
        SBAR(); qkt(pA0, pA1, K_lds, qr, r32, hi);
        finishSM(pB0, pB1, alB, l_reg, pa0, pa1, pa2, pa3); SBAR();
        if (j + 3 < NT) SLOAD(SE, (j + 3) * KVBLK); SBAR();
        pv_d0(o, vb0 + (int)SHM_V, pa0, pa1, pa2, pa3); partialSM(pA0, pA1, m_reg, mnA, alA);
        __syncthreads(); SWAIT(); SWRITE(1, SO);
        RESC(alA); __syncthreads();
    }
    SBAR(); qkt(pB0, pB1, (bf16_t*)((char*)K_lds + SHM_K), qr, r32, hi);
    finishSM(pA0, pA1, alA, l_reg, pa0, pa1, pa2, pa3); SBAR();
    pv_d0(o, vb0, pa0, pa1, pa2, pa3); partialSM(pB0, pB1, m_reg, mnB, alB);
    __syncthreads(); RESC(alB);
    finishSM(pB0, pB1, alB, l_reg, pa0, pa1, pa2, pa3); SBAR();
    pv_d0(o, vb0 + (int)SHM_V, pa0, pa1, pa2, pa3);
    if (hi == 0) li_l[r32] = l_reg; asm volatile("s_waitcnt lgkmcnt(0)" ::: "memory");
    float rli[16];
#pragma unroll
    for (int r = 0; r < 16; ++r) rli[r] = __builtin_amdgcn_rcpf(li_l[crow(r, hi)]);
    bf16_t* Ow = Ob + (long)(wid * QBLK) * LDO;
#pragma unroll
    for (int r = 0; r < 16; ++r) { int orow = crow(r, hi);
#pragma unroll
        for (int d0 = 0; d0 < 4; ++d0) Ow[(long)orow * LDO + d0 * 32 + r32] = (bf16_t)(cvt_pk_bf16(o[d0][r] * rli[r], 0.f) & 0xffffu); }
#undef SLOAD
#undef SWRITE
#undef SWAIT
#undef RESC
}
}

__device__ __forceinline__ void p0_transpose_item(const float* W, int K, int N, bf16_t* WT, LAS float* scr, int item, int lane, const float* kscale, int ileave = 0) {
    const int nblk = N / 32, kb = item / nblk, nb = item % nblk, k0 = 64 * kb, n0 = 32 * nb;
    const int d0 = !ileave ? n0 : (n0 < DFF ? 256 * (n0 >> 7) + (n0 & 127) : 256 * ((n0 - DFF) >> 7) + 128 + ((n0 - DFF) & 127));
#pragma unroll 8
    for (int i = 0; i < 32; ++i) { const int kk = 2 * i + (lane >> 5); float v = W[(size_t)(k0 + kk) * N + n0 + (lane & 31)]; if (kscale) v *= kscale[k0 + kk]; scr[kk * 33 + (lane & 31)] = v; }
    asm volatile("s_waitcnt lgkmcnt(0)" ::: "memory");
    const int c = lane & 7;
#pragma unroll
    for (int j = 0; j < 4; ++j) { const int n = (lane >> 3) + 8 * j; const LAS float* s = scr + (8 * c) * 33 + n;
        u32x4 o; o.x = cvt_pk_bf16(s[0 * 33], s[1 * 33]); o.y = cvt_pk_bf16(s[2 * 33], s[3 * 33]); o.z = cvt_pk_bf16(s[4 * 33], s[5 * 33]); o.w = cvt_pk_bf16(s[6 * 33], s[7 * 33]);
        *(u32x4*)(WT + (size_t)(d0 + n) * K + k0 + 8 * c) = o; }
    asm volatile("s_waitcnt lgkmcnt(0)" ::: "memory");
}

__device__ __forceinline__ void phase_p0(KP P, LAS unsigned char* lds, int G, const int tidx_, const int bidx_) {
    const int tid = tidx_, wid = __builtin_amdgcn_readfirstlane(tid >> 6), lane = tid & 63;
    unsigned char* ws = P->ws;
    {
        LAS float* SC = (LAS float*)lds;
        LAS float* RED = (LAS float*)(lds + 36864);
        bool have = false;
        for (int task = bidx_; task < 192; task += G) {
            if (!have) {
                for (int idx = tid; idx < 9 * 1024; idx += 512) { const int row = idx >> 10, k = idx & 1023; const float v = row < 8 ? P->in[I_C][row * 1024 + k] : P->in[I_CCTX][k]; SC[idx] = v / (1.f + expf(-v)); }
                __syncthreads(); have = true;
            }
            const int layer = task / 96, n0 = (task % 96) * 64;
            const float* W = P->in[I_ADAW] + (size_t)layer * 1024 * 6144 + n0 + lane;
            float a[9];
#pragma unroll
            for (int r = 0; r < 9; ++r) a[r] = 0.f;
            const int kbeg = wid * 128;
#pragma unroll 8
            for (int k = 0; k < 128; ++k) { const float w = W[(size_t)(kbeg + k) * 6144];
#pragma unroll
                for (int r = 0; r < 9; ++r) a[r] += SC[r * 1024 + kbeg + k] * w; }
#pragma unroll
            for (int r = 0; r < 9; ++r) RED[(wid * 9 + r) * 64 + lane] = a[r];
            __syncthreads();
            for (int idx = tid; idx < 576; idx += 512) { const int r = idx >> 6, l = idx & 63; float s = P->in[I_ADAB][layer * 6144 + n0 + l];
#pragma unroll
                for (int w = 0; w < 8; ++w) s += RED[(w * 9 + r) * 64 + l];
                ((float*)(ws + WS_MOD))[(layer * 9 + r) * 6144 + n0 + l] = s; }
            __syncthreads();
        }
        __syncthreads();
    }
    {
        const int gt = bidx_ * 512 + tid, NT = G * 512;
        float* rs = (float*)(ws + WS_ROWSS);
        for (int i = gt; i < MT; i += NT) rs[i] = 0.f;
        u32x4* pz = (u32x4*)(ws + W_SIN + (size_t)INC * 1024 * 2);
        for (int i = gt; i < (SINP - INC) * 1024 / 8; i += NT) pz[i] = (u32x4){0u, 0u, 0u, 0u};
    }
    {
        LAS float* scr = (LAS float*)(lds + wid * 8448);
        const int gw = bidx_ * 8 + wid, NGW = G * 8;
        constexpr int I0 = 16 * 48, I1 = 16 * 32, I2 = 16 * 176, I3 = 44 * 32, I4 = 16 * 162, I5 = 32 * 32;
        constexpr int NIT = I0 + I1 + 2 * I2 + 2 * I3 + I4 + I5;
        for (int it = gw; it < NIT; it += NGW) {
            int r = it;
            if (r < I0) { p0_transpose_item(P->in[I_AWIN], 1024, INA, (bf16_t*)(ws + W_AIN), scr, r, lane, nullptr); continue; } r -= I0;
            if (r < I1) { p0_transpose_item(P->in[I_AWOUT], 1024, 1024, (bf16_t*)(ws + W_AOUT), scr, r, lane, nullptr); continue; } r -= I1;
            if (r < I2) { p0_transpose_item(P->in[I_FUP], 1024, DFF2, (bf16_t*)(ws + W_UP0), scr, r, lane, nullptr, 1); continue; } r -= I2;
            if (r < I2) { p0_transpose_item(P->in[I_FUP] + (size_t)1024 * DFF2, 1024, DFF2, (bf16_t*)(ws + W_UP1), scr, r, lane, nullptr, 1); continue; } r -= I2;
            if (r < I3) { p0_transpose_item(P->in[I_FDN], DFF, 1024, (bf16_t*)(ws + W_DN0), scr, r, lane, nullptr); continue; } r -= I3;
            if (r < I3) { p0_transpose_item(P->in[I_FDN] + (size_t)DFF * 1024, DFF, 1024, (bf16_t*)(ws + W_DN1), scr, r, lane, nullptr); continue; } r -= I3;
            if (r < I4) { p0_transpose_item(P->in[I_SWIN], 1024, INC, (bf16_t*)(ws + W_SIN), scr, r, lane, nullptr); continue; } r -= I4;
            p0_transpose_item(P->in[I_SWOUT], DIN, 1024, (bf16_t*)(ws + W_SOUT), scr, r, lane, P->in[I_SNW]);
        }
    }
}

struct RwDesc { int rows, rspace, layer, layerB; const float* srcL; const float* srcC; const bf16_t* xsrc; bf16_t* xdst; float* odst; const bf16_t* Y; const float* nwA; int gate_k; const float* nwB; int shift_k, scale_k; bf16_t* XN; };
__device__ __forceinline__ void phase_rw(KP P, const RwDesc d, int G, const int tidx_, const int bidx_) {
    const int tid = tidx_, wid = tid >> 6, lane = tid & 63;
    const int gw = bidx_ * 8 + wid, NGW = G * 8;
    const float* MOD = (const float*)(P->ws + WS_MOD) + (size_t)d.layer * 9 * 6144;
    const float* MODB = (const float*)(P->ws + WS_MOD) + (size_t)d.layerB * 9 * 6144;
    const int nk = (d.rows - gw + NGW - 1) / NGW;
    const int r0 = 0, r1 = nk;
#define RW_ROW(k_) (gw + (k_) * NGW)
#define RW_SROW(r_) (d.rspace ? (r_) : (r_) + CTXL * (((r_) >> 13) + 1))
    f32x4 vnA[4], vgt[4], vnB[4], vsh[4], vsc[4]; int cur = -1;
#pragma unroll
    for (int j = 0; j < 4; ++j) { vnA[j] = d.nwA ? *(const f32x4*)(d.nwA + 4 * lane + 256 * j) : (f32x4){0.f, 0.f, 0.f, 0.f}; vnB[j] = d.nwB ? *(const f32x4*)(d.nwB + 4 * lane + 256 * j) : (f32x4){0.f, 0.f, 0.f, 0.f}; }
#define RW_ADDR(r_, src_, mrow_) do { const int rc_ = (r_); \
        if (d.rspace) { const int b_ = rc_ / RPB, j_ = rc_ - b_ * RPB; \
            if (j_ < CTXL) { src_ = d.srcC + (size_t)(b_ * CTXL + j_) * DM; mrow_ = 8; } \
            else { src_ = d.srcL + (size_t)(b_ * SEQ + j_ - CTXL) * DM; mrow_ = b_; } \
        } else { src_ = d.srcL + (size_t)rc_ * DM; mrow_ = rc_ / SEQ; } } while (0)
#define RW_LOAD(XV, XQ, YQ, rbase_) do { _Pragma("unroll") for (int k = 0; k < 2; ++k) { const int kk_ = ((rbase_) + k < r1) ? (rbase_) + k : r1 - 1; const int rc2_ = RW_ROW(kk_); \
        if (d.xsrc) { const bf16_t* s2_ = d.xsrc + (size_t)RW_SROW(rc2_) * DM; _Pragma("unroll") for (int j = 0; j < 4; ++j) XQ[k][j] = *(const u32x2*)(s2_ + 4 * lane + 256 * j); } \
        else { const float* s_; int m_; RW_ADDR(rc2_, s_, m_); (void)m_; _Pragma("unroll") for (int j = 0; j < 4; ++j) XV[k][j] = *(const f32x4*)(s_ + 4 * lane + 256 * j); } \
        if (d.Y) { _Pragma("unroll") for (int j = 0; j < 4; ++j) YQ[k][j] = *(const u32x2*)(d.Y + (size_t)rc2_ * DM + 4 * lane + 256 * j); } } } while (0)
    f32x4 xv[2][4], xn[2][4]; u32x2 xq[2][4], xqn[2][4], yq[2][4], yn[2][4];
    if (r0 < r1) RW_LOAD(xv, xq, yq, r0);
    for (int rr = r0; rr < r1; rr += 2) {
        if (rr + 2 < r1) RW_LOAD(xn, xqn, yn, rr + 2);
#pragma unroll
        for (int k = 0; k < 2; ++k) {
            if (rr + k >= r1) continue;
            const int r = RW_ROW(rr + k);
            int mrowk;
            if (d.rspace) { const int b_ = r / RPB, j_ = r - b_ * RPB; mrowk = j_ < CTXL ? 8 : b_; } else mrowk = r / SEQ;
            if (mrowk != cur) { cur = mrowk; const float* mod = MOD + (size_t)cur * 6144; const float* modb = MODB + (size_t)cur * 6144;
#pragma unroll
                for (int j = 0; j < 4; ++j) { vgt[j] = *(const f32x4*)(mod + d.gate_k * 1024 + 4 * lane + 256 * j); vsh[j] = *(const f32x4*)(modb + d.shift_k * 1024 + 4 * lane + 256 * j);
                    vsc[j] = *(const f32x4*)(modb + d.scale_k * 1024 + 4 * lane + 256 * j); } }
            if (d.xsrc) {
#pragma unroll
                for (int j = 0; j < 4; ++j) { const u32x2 q = xq[k][j]; xv[k][j] = (f32x4){bflo(q.x), bfhi(q.x), bflo(q.y), bfhi(q.y)}; }
            }
            if (d.Y) {
                f32x4 yv[4]; float ss = 0.f;
#pragma unroll
                for (int j = 0; j < 4; ++j) { const u32x2 q = yq[k][j];
                    yv[j] = (f32x4){bflo(q.x), bfhi(q.x), bflo(q.y), bfhi(q.y)}; ss += (yv[j].x * yv[j].x + yv[j].y * yv[j].y) + (yv[j].z * yv[j].z + yv[j].w * yv[j].w); }
                const float rstd = rsqrtf(wave_sum(ss, lane) * (1.f / DM) + EPS);
#pragma unroll
                for (int j = 0; j < 4; ++j) xv[k][j] = xv[k][j] + vgt[j] * (yv[j] * rstd * vnA[j]);
                if (d.xdst) { bf16_t* xd = d.xdst + (size_t)RW_SROW(r) * DM;
#pragma unroll
                    for (int j = 0; j < 4; ++j) { u32x2 o; o.x = cvt_pk_bf16(xv[k][j].x, xv[k][j].y); o.y = cvt_pk_bf16(xv[k][j].z, xv[k][j].w); *(u32x2*)(xd + 4 * lane + 256 * j) = o; }
                }
                if (d.odst) { float* od = d.odst + (size_t)r * DM;
#pragma unroll
                    for (int j = 0; j < 4; ++j) *(f32x4*)(od + 4 * lane + 256 * j) = xv[k][j];
                }
            }
            if (d.XN) {
                float ss = 0.f;
#pragma unroll
                for (int j = 0; j < 4; ++j) ss += (xv[k][j].x * xv[k][j].x + xv[k][j].y * xv[k][j].y) + (xv[k][j].z * xv[k][j].z + xv[k][j].w * xv[k][j].w);
                const float rstd = rsqrtf(wave_sum(ss, lane) * (1.f / DM) + EPS);
#pragma unroll
                for (int j = 0; j < 4; ++j) { const f32x4 h = (xv[k][j] * rstd * vnB[j]) * (vsc[j] + 1.f) + vsh[j];
                    u32x2 o; o.x = cvt_pk_bf16(h.x, h.y); o.y = cvt_pk_bf16(h.z, h.w);
                    *(u32x2*)(d.XN + (size_t)r * DM + 4 * lane + 256 * j) = o; }
            }
        }
#pragma unroll
        for (int k = 0; k < 2; ++k)
#pragma unroll
            for (int j = 0; j < 4; ++j) { xv[k][j] = xn[k][j]; xq[k][j] = xqn[k][j]; yq[k][j] = yn[k][j]; }
    }
#undef RW_ADDR
#undef RW_LOAD
#undef RW_ROW
#undef RW_SROW
}

__device__ __forceinline__ void phase_qkp(KP P, LAS unsigned char* lds, int G, const int tidx_, const int bidx_) {
    const int tid = tidx_, wid = tid >> 6, lane = tid & 63;
    bf16_t* U = (bf16_t*)(P->ws + BIG_U); bf16_t* MIX = (bf16_t*)(P->ws + BIG_MIX);
    LAS float* PW = (LAS float*)lds;
    for (int i = tid; i < 4 * 64 * 64; i += 512) PW[i] = P->in[I_POOLW][i];
    LAS float* ROPE = (LAS float*)(lds + 65536);
    for (int i = tid; i < 192 * 32; i += 512) { const int pidx = i >> 5, m = i & 31; const float pos = (float)(pidx < 128 ? pidx : pidx - 128);
        float sn, cs; sincosf(pos * powf(10000.f, -(float)m / 32.f), &sn, &cs); ROPE[2 * i] = cs; ROPE[2 * i + 1] = sn; }
    __syncthreads();
    const int head = lane >> 3, l8 = lane & 7;
    const float* gain = (head < 6 ? P->in[I_QG] : P->in[I_KG]) + l8 * 16;
    float gn[16];
#pragma unroll
    for (int e = 0; e < 16; ++e) gn[e] = gain[e];
    const bool use_row = l8 < 4;
    float psc[4];
#pragma unroll
    for (int g = 0; g < 4; ++g) psc[g] = P->in[I_POOLS][g * 64 + lane];
    const int gw = bidx_ * 8 + wid, NGW = G * 8;
    for (int r = gw; r < MR; r += NGW) {
        const int b = r / RPB, j = r - b * RPB; const bool isctx = j < CTXL;
        const int t = isctx ? j : j - CTXL, T = isctx ? CTXL : SEQ;
        bf16_t* urow = U + (size_t)r * INA;
        {
            const u32x4 q0 = *(const u32x4*)(urow + 256 + 16 * lane), q1 = *(const u32x4*)(urow + 256 + 16 * lane + 8);
            float v[16]; { float a[8], c[8]; unpack8(q0, a); unpack8(q1, c);
#pragma unroll
                for (int e = 0; e < 8; ++e) { v[e] = a[e]; v[8 + e] = c[e]; } }
            float ss = 0.f;
#pragma unroll
            for (int e = 0; e < 16; ++e) ss += v[e] * v[e];
            ss += shx(ss, 1, lane); ss += shx(ss, 2, lane); ss += shx(ss, 4, lane);
            const float rstd = rsqrtf(ss * (1.f / 128.f) + EPS);
#pragma unroll
            for (int e = 0; e < 16; ++e) v[e] = v[e] * rstd * gn[e];
            if (!isctx) {
                const int pidx = use_row ? (t >> 6) : 128 + (t & 63);
#pragma unroll
                for (int i = 0; i < 8; ++i) { const int m = (l8 & 3) * 8 + i; const float cs = ROPE[(pidx * 32 + m) * 2], sn = ROPE[(pidx * 32 + m) * 2 + 1];
                    const float x1 = v[2 * i], x2 = v[2 * i + 1]; v[2 * i] = x1 * cs - x2 * sn; v[2 * i + 1] = x1 * sn + x2 * cs; }
            }
            float a[8], c[8];
#pragma unroll
            for (int e = 0; e < 8; ++e) { a[e] = v[e]; c[e] = v[8 + e]; }
            *(u32x4*)(urow + 256 + 16 * lane) = pack8(a); *(u32x4*)(urow + 256 + 16 * lane + 8) = pack8(c);
        }
#pragma unroll
        for (int g = 0; g < 4; ++g) {
            const int w = 2 << g, left = w >> 1, right = w - 1 - left;
            const int lo = (t - left) > 0 ? (t - left) : 0, hi = (t + right) < (T - 1) ? (t + right) : (T - 1);
            float s = 0.f;
            for (int tt = lo; tt <= hi; ++tt) s += bflo((unsigned)urow[(long)(tt - t) * INA + g * 64 + lane]);
            const float self = bflo((unsigned)urow[g * 64 + lane]);
            const float part = s / (float)(hi - lo + 1) - self;
            float y = 0.f;
#pragma unroll 16
            for (int i = 0; i < 64; ++i) y += rdlane(part, i) * PW[(g * 64 + i) * 64 + lane];
            y *= psc[g];
            MIX[(size_t)r * DM + g * 64 + lane] = (bf16_t)(cvt_pk_bf16(y, 0.f) & 0xffffu);
        }
    }
}

__device__ __forceinline__ void attn_unit(KP P, char* lds, int b, int h, int qb, bool ctx, const int tidx_) {
    bf16_t* U = (bf16_t*)(P->ws + BIG_U); bf16_t* MIX = (bf16_t*)(P->ws + BIG_MIX);
    const int kvh = h / 3;
    const size_t R0 = (size_t)b * RPB, RQ = ctx ? R0 : R0 + CTXL + (size_t)qb * 256;
    att::attn_dense_body(U + RQ * INA + 256 + h * 128, U + R0 * INA + 1024 + kvh * 128, U + R0 * INA + 1280 + kvh * 128,
                         MIX + RQ * DM + 256 + h * 128, ctx ? CTXL : RPB, lds, tidx_);
    __syncthreads();
}
__device__ __forceinline__ void phase_attn(KP P, char* lds, int G, const int tidx_, const int bidx_) {
    const int bid = bidx_;
    const int nlat = (G == 256) ? 6 : (1536 - bid + G - 1) / G;
    const int nctx = (bid < 48) ? (48 - bid + G - 1) / G : 0;
    for (int i = 0; i < nlat + nctx; ++i) {
        int b, h, qb; bool ctx;
        if (i < nlat) {
            int grp, idx;
            if (G == 256) { const int xcd = bid & 7, cu = bid >> 3; grp = 2 * xcd + i / 3; idx = (i % 3) * 32 + cu; }
            else { const int u = bid + i * G; grp = u / 96; idx = u % 96; }
            b = grp >> 1; h = (grp & 1) * 3 + (idx >> 5); qb = idx & 31; ctx = false;
        } else { const int u = bid + (i - nlat) * G; b = u / 6; h = u % 6; qb = 0; ctx = true; }
        attn_unit(P, lds, b, h, qb, ctx, tidx_);
    }
}

__device__ __forceinline__ bool seq_first(int r0, int rspace) { if (rspace) { const int j = r0 % RPB; return j == 0 || j == CTXL; } return (r0 % SEQ) == 0; }
__device__ __forceinline__ bool seq_last(int r0, int rspace) { if (rspace) { const int j = (r0 + 64) % RPB; return j == 0 || j == CTXL; } return ((r0 + 64) % SEQ) == 0; }

__device__ __forceinline__ void phase_halo_f(KP P, int rows, int G, const int tidx_, const int bidx_) {
    const bf16_t* UP = (const bf16_t*)(P->ws + BIG_UP); bf16_t* HL = (bf16_t*)(P->ws + WS_HALO);
    const long total = (long)(rows / 64) * 2 * 704;
    for (long idx = (long)bidx_ * 512 + tidx_; idx < total; idx += (long)G * 512) {
        const int v = (int)(idx % 704); const long q = idx / 704; const int w = (int)(q & 1); const long rb = q >> 1;
        const long row = rb * 64 + (w ? 63 : 0);
        *(u32x4*)(HL + (size_t)q * DFF2 + 8 * v) = *(const u32x4*)(UP + (size_t)row * DFF2 + 8 * v);
    }
}
__device__ __forceinline__ void phase_cg(KP P, int rows, int rspace, int layer, int G, const int tidx_, const int bidx_) {
    bf16_t* UP = (bf16_t*)(P->ws + BIG_UP); const bf16_t* HL = (const bf16_t*)(P->ws + WS_HALO);
    const float* CW = P->in[I_FCW] + (size_t)layer * DFF2 * 3; const float* CB = P->in[I_FCB] + (size_t)layer * DFF2;
    const long total = (long)(rows / 64) * 352;
    const u32x4 Z4 = (u32x4){0u, 0u, 0u, 0u};
    for (long idx = (long)bidx_ * 512 + tidx_; idx < total; idx += (long)G * 512) {
        const int v = (int)(idx % 352); const int rb = (int)(idx / 352); const int r0 = rb * 64;
        const bool first = seq_first(r0, rspace), last = seq_last(r0, rspace);
        float wv[8][3], wg[8][3], bv[8], bg[8];
#pragma unroll
        for (int e = 0; e < 8; ++e) {
#pragma unroll
            for (int k = 0; k < 3; ++k) { wv[e][k] = CW[(8 * v + e) * 3 + k]; wg[e][k] = CW[(DFF + 8 * v + e) * 3 + k]; }
            bv[e] = CB[8 * v + e]; bg[e] = CB[DFF + 8 * v + e]; }
        u32x4 pv_ = first ? Z4 : *(const u32x4*)(HL + ((size_t)(rb - 1) * 2 + 1) * DFF2 + 8 * v);
        u32x4 pg_ = first ? Z4 : *(const u32x4*)(HL + ((size_t)(rb - 1) * 2 + 1) * DFF2 + DFF + 8 * v);
        bf16_t* base = UP + (size_t)r0 * DFF2 + 8 * v;
        u32x4 cv_ = *(const u32x4*)base, cg_ = *(const u32x4*)(base + DFF);
        u32x4 nv_ = *(const u32x4*)(base + (size_t)DFF2), ng_ = *(const u32x4*)(base + (size_t)DFF2 + DFF);
        const u32x4 hv_ = last ? Z4 : *(const u32x4*)(HL + ((size_t)(rb + 1) * 2) * DFF2 + 8 * v), hg_ = last ? Z4 : *(const u32x4*)(HL + ((size_t)(rb + 1) * 2) * DFF2 + DFF + 8 * v);
        for (int t = 0; t < 64; ++t) {
            u32x4 fv_ = hv_, fg_ = hg_;
            if (t + 2 < 64) { fv_ = *(const u32x4*)(base + (size_t)(t + 2) * DFF2); fg_ = *(const u32x4*)(base + (size_t)(t + 2) * DFF2 + DFF); }
            float a0[8], a1[8], a2[8], g0[8], g1[8], g2[8], o[8];
            unpack8(pv_, a0); unpack8(cv_, a1); unpack8(nv_, a2); unpack8(pg_, g0); unpack8(cg_, g1); unpack8(ng_, g2);
#pragma unroll
            for (int e = 0; e < 8; ++e) { const float val = bv[e] + wv[e][0] * a0[e] + wv[e][1] * a1[e] + wv[e][2] * a2[e];
                const float gt = bg[e] + wg[e][0] * g0[e] + wg[e][1] * g1[e] + wg[e][2] * g2[e]; o[e] = siluf(gt) * val; }
            *(u32x4*)(base + (size_t)t * DFF2) = pack8(o);
            pv_ = cv_; pg_ = cg_; cv_ = nv_; cg_ = ng_; nv_ = fv_; ng_ = fg_;
        }
    }
}
__device__ __forceinline__ void phase_halo_s(KP P, int G, const int tidx_, const int bidx_) {
    const bf16_t* XBC = (const bf16_t*)(P->ws + BIG_XBC); bf16_t* HL = (bf16_t*)(P->ws + WS_HALO);
    const long total = (long)(MR / 64) * 3 * 384;
    for (long idx = (long)bidx_ * 512 + tidx_; idx < total; idx += (long)G * 512) {
        const int v = (int)(idx % 384); const long q = idx / 384; const int w = (int)(q % 3); const long rb = q / 3;
        const long row = rb * 64 + (w == 0 ? 0 : 61 + w);
        *(u32x4*)(HL + (size_t)q * CONVD + 8 * v) = *(const u32x4*)(XBC + (size_t)row * CONVD + 8 * v);
    }
}
__device__ __forceinline__ void phase_conv_s(KP P, int G, const int tidx_, const int bidx_) {
    bf16_t* XBC = (bf16_t*)(P->ws + BIG_XBC); const bf16_t* HL = (const bf16_t*)(P->ws + WS_HALO);
    const float* CW = P->in[I_SCW]; const float* CB = P->in[I_SCB];
    const long total = (long)(MR / 64) * 384;
    const u32x4 Z4 = (u32x4){0u, 0u, 0u, 0u};
    for (long idx = (long)bidx_ * 512 + tidx_; idx < total; idx += (long)G * 512) {
        const int v = (int)(idx % 384); const int rb = (int)(idx / 384); const int r0 = rb * 64;
        const bool first = seq_first(r0, 1), last = seq_last(r0, 1);
        float w[8][4], bb[8];
#pragma unroll
        for (int e = 0; e < 8; ++e) { const f32x4 q = *(const f32x4*)(CW + (size_t)(8 * v + e) * 4); w[e][0] = q.x; w[e][1] = q.y; w[e][2] = q.z; w[e][3] = q.w; bb[e] = CB[8 * v + e]; }
        u32x4 pp = first ? Z4 : *(const u32x4*)(HL + ((size_t)(rb - 1) * 3 + 1) * CONVD + 8 * v);
        u32x4 p1 = first ? Z4 : *(const u32x4*)(HL + ((size_t)(rb - 1) * 3 + 2) * CONVD + 8 * v);
        bf16_t* base = XBC + (size_t)r0 * CONVD + 8 * v;
        u32x4 cu = *(const u32x4*)base, nx = *(const u32x4*)(base + (size_t)CONVD);
        const u32x4 hx = last ? Z4 : *(const u32x4*)(HL + ((size_t)(rb + 1) * 3) * CONVD + 8 * v);
        for (int t = 0; t < 64; ++t) {
            u32x4 fx = hx;
            if (t + 2 < 64) fx = *(const u32x4*)(base + (size_t)(t + 2) * CONVD);
            float a0[8], a1[8], a2[8], a3[8], o[8];
            unpack8(pp, a0); unpack8(p1, a1); unpack8(cu, a2); unpack8(nx, a3);
#pragma unroll
            for (int e = 0; e < 8; ++e) { const float a = bb[e] + w[e][0] * a0[e] + w[e][1] * a1[e] + w[e][2] * a2[e] + w[e][3] * a3[e]; o[e] = siluf(a); }
            *(u32x4*)(base + (size_t)t * CONVD) = pack8(o);
            pp = p1; p1 = cu; cu = nx; nx = fx;
        }
    }
}

__device__ __forceinline__ unsigned offb(unsigned R, unsigned ch) { return 256u * R + 16u * (ch ^ (((R & 3u) << 2) | ((R >> 2) & 3u))); }
__device__ __forceinline__ bf16x8 rowfrag(LAS const unsigned char* tile, int rb, int s, int lane) {
    return *(LAS const bf16x8*)(tile + offb(32 * rb + (lane & 31), 2 * s + (lane >> 5)));
}
__device__ __forceinline__ s16x4 trd(LAS const unsigned char* p) { return __builtin_bit_cast(s16x4, __builtin_amdgcn_ds_read_tr16_b64_v4i16((LAS v4i16_t*)p)); }
__device__ __forceinline__ bf16x8 trfrag(LAS const unsigned char* tile, int c, int ks, int lane) {
    const unsigned h = lane >> 5, blk = (lane >> 4) & 1, q = (lane & 15) >> 2, p = lane & 3;
    const unsigned ch = 4 * c + 2 * blk + (p >> 1), r0 = 16 * ks + 8 * h + q;
    const s16x4 lo = trd(tile + offb(r0, ch) + 8 * (p & 1)), hi = trd(tile + offb(r0 + 4, ch) + 8 * (p & 1));
    return (bf16x8){lo[0], lo[1], lo[2], lo[3], hi[0], hi[1], hi[2], hi[3]};
}

__device__ __forceinline__ void phase_ssd(KP P, LAS unsigned char* lds, int G, const int tidx_, const int bidx_) {
    const int tid = tidx_, wid = __builtin_amdgcn_readfirstlane(tid >> 6), lane = tid & 63, r32 = lane & 31, hi = lane >> 5;
    LAS unsigned char* BT = lds; LAS unsigned char* CT = lds + 32768; LAS unsigned char* X2 = lds + 65536; LAS unsigned char* HS = lds + 98304;
    LAS float* sarr = (LAS float*)(lds + 114688);
    LAS float* dts = (LAS float*)(lds + 120832);
    LAS float* YST = (LAS float*)(lds + 121856);
    const bf16_t* XBC = (const bf16_t*)(P->ws + BIG_XBC); const float* DT = (const float*)(P->ws + BIG_DT); bf16_t* YS = (bf16_t*)(P->ws + BIG_YS);
    const int lb = (wid < 4) ? (wid >> 1) : (wid < 6 ? 3 : 2), pb = wid & 1;
    for (int u = bidx_; u < NB * 32; u += G) {
        const int b = (G == 256) ? (u & 7) : (u >> 5), h = (G == 256) ? (u >> 3) : (u & 31), g = h >> 3;
        const float Dk = P->in[I_SD][h];
        for (int dir = 0; dir < 2; ++dir) {
            const float A = -expf(P->in[I_SALOG][dir * 32 + h]);
            const int sgn = dir ? -1 : 1;
            f32x16 hacc = {};
            for (int i = tid; i < 1024; i += 512) *(LAS u32x4*)(HS + 16 * i) = (u32x4){0u, 0u, 0u, 0u};
            u32x4 pfB[4], pfC[4], pfX[2]; float dT0 = 0.f, dT1 = 0.f;
#define SSD_J0(c) ((c) < 2 ? (dir ? 255 - 128 * (c) : 128 * (c)) : (dir ? 8447 - 128 * ((c) - 2) : 256 + 128 * ((c) - 2)))
#define SSD_PREFETCH(c) do { const int j0_ = SSD_J0(c); const size_t rbase_ = (size_t)b * RPB; \
    _Pragma("unroll") for (int i = 0; i < 4; ++i) { const int v = tid + 512 * i, l = v >> 4, ch = v & 15; const bf16_t* rp = XBC + (rbase_ + j0_ + sgn * l) * CONVD; \
        pfB[i] = *(const u32x4*)(rp + 2048 + g * 128 + 8 * ch); pfC[i] = *(const u32x4*)(rp + 2560 + g * 128 + 8 * ch); } \
    _Pragma("unroll") for (int i = 0; i < 2; ++i) { const int v = tid + 512 * i, l = v >> 3, xc = v & 7; pfX[i] = *(const u32x4*)(XBC + (rbase_ + j0_ + sgn * l) * CONVD + h * 64 + 8 * xc); } \
    } while (0)
#define SSD_LOADDT(c_, d0_, d1_) do { const int jd_ = SSD_J0(c_); const size_t rb_ = (size_t)b * RPB; int ln_ = lane; asm volatile("" : "+v"(ln_));   \
    d0_ = DT[(rb_ + jd_ + sgn * (2 * ln_)) * 64 + dir * 32 + h]; d1_ = DT[(rb_ + jd_ + sgn * (2 * ln_ + 1)) * 64 + dir * 32 + h]; } while (0)
#define SSD_SCAN(buf_, pfd0, pfd1) do { LAS float* ac_ = sarr + (buf_) * 512; const float a0 = pfd0 * A, a1 = pfd1 * A; float incl = a0 + a1; \
    _Pragma("unroll") for (int o = 1; o < 64; o <<= 1) { const float t = shup(incl, o, lane); if (lane >= o) incl += t; } \
    const float tot = rdlane(incl, 63); const float c0 = incl - a1; \
    ac_[2 * lane] = c0; ac_[2 * lane + 1] = incl; ac_[128 + 2 * lane] = __expf(c0); ac_[128 + 2 * lane + 1] = __expf(incl); \
    ac_[256 + 2 * lane] = pfd0; ac_[256 + 2 * lane + 1] = pfd1; ac_[384 + 2 * lane] = __expf(tot - c0); ac_[384 + 2 * lane + 1] = __expf(tot - incl); } while (0)
#define SSD_TILES(buf_) do { LAS float* dtv_ = sarr + (buf_) * 512 + 256; LAS float* wdec_ = dtv_ + 128; \
    _Pragma("unroll") for (int i = 0; i < 4; ++i) { const int v = tid + 512 * i, l = v >> 4, ch = v & 15; *(LAS u32x4*)(BT + offb(l, ch)) = pfB[i]; *(LAS u32x4*)(CT + offb(l, ch)) = pfC[i]; } \
    _Pragma("unroll") for (int i = 0; i < 2; ++i) { const int v = tid + 512 * i, l = v >> 3, xc = v & 7; float f[8], xd[8], xw[8]; unpack8(pfX[i], f); const float d = dtv_[l], w = wdec_[l]; \
        _Pragma("unroll") for (int e = 0; e < 8; ++e) { xd[e] = f[e] * d; xw[e] = xd[e] * w; } \
        *(LAS u32x4*)(X2 + offb(l, xc)) = pack8(xd); *(LAS u32x4*)(X2 + offb(l, 8 + xc)) = pack8(xw); } } while (0)
            SSD_PREFETCH(0);
            if (wid == 0) { float e0, e1; SSD_LOADDT(0, dT0, dT1); SSD_LOADDT(1, e0, e1); SSD_SCAN(0, dT0, dT1); SSD_SCAN(1, e0, e1);
                SSD_LOADDT(2, e0, e1); dts[2 * lane] = e0; dts[2 * lane + 1] = e1; SSD_LOADDT(3, dT0, dT1); }
            __syncthreads();
            SSD_TILES(0);
            SSD_PREFETCH(1);
            __syncthreads();
            int c3 = 0;
            for (int c = 0; c < 66; ++c) {
                const int j0 = SSD_J0(c);
                const bool outp = c >= 2;
                LAS float* acum = sarr + c3 * 512; LAS float* eac = acum + 128;
                const int c3n = (c3 == 2) ? 0 : c3 + 1, c3nn = (c3n == 2) ? 0 : c3n + 1;
                f32x16 yacc = {}, sacc = {};
                if (outp) {
                    const float al = acum[32 * lb + r32];
                    for (int sb = 0; sb <= lb; ++sb) {
                        f32x16 accT = {};
#pragma unroll
                        for (int s = 0; s < 8; ++s) accT = __builtin_amdgcn_mfma_f32_32x32x16_bf16(rowfrag(BT, sb, s, lane), rowfrag(CT, lb, s, lane), accT, 0, 0, 0);
                        float val[16];
#pragma unroll
                        for (int qd = 0; qd < 4; ++qd) { const f32x4 as = *(LAS const f32x4*)(acum + 32 * sb + 8 * qd + 4 * hi);
#pragma unroll
                            for (int e = 0; e < 4; ++e) { const int sidx = 32 * sb + 8 * qd + 4 * hi + e, lidx = 32 * lb + r32; val[4 * qd + e] = (sidx <= lidx) ? accT[4 * qd + e] * __expf(al - as[e]) : 0.f; } }
                        bf16x8 ma0, ma1; PK4(val, 0, ma0); PK4(val, 8, ma1);
                        yacc = __builtin_amdgcn_mfma_f32_32x32x16_bf16(ma0, trfrag(X2, pb, 2 * sb, lane), yacc, 0, 0, 0);
                        yacc = __builtin_amdgcn_mfma_f32_32x32x16_bf16(ma1, trfrag(X2, pb, 2 * sb + 1, lane), yacc, 0, 0, 0);
                    }
#pragma unroll
                    for (int g4 = 0; g4 < 2; ++g4) {
                        bf16x8 cfr[4], hfr[4];
#pragma unroll
                        for (int s = 0; s < 4; ++s) { cfr[s] = rowfrag(CT, lb, 4 * g4 + s, lane); hfr[s] = rowfrag(HS, pb, 4 * g4 + s, lane); }
#pragma unroll
                        for (int s = 0; s < 4; ++s) sacc = __builtin_amdgcn_mfma_f32_32x32x16_bf16(cfr[s], hfr[s], sacc, 0, 0, 0);
                    }
                }
                {
                    const float etot = eac[127];
#pragma unroll
                    for (int r = 0; r < 16; ++r) hacc[r] *= etot;
#pragma unroll
                    for (int g4 = 0; g4 < 2; ++g4) {
                        bf16x8 af[4], xw[4];
#pragma unroll
                        for (int ks = 0; ks < 4; ++ks) { af[ks] = trfrag(BT, lb, 4 * g4 + ks, lane); xw[ks] = trfrag(X2, 2 + pb, 4 * g4 + ks, lane); }
#pragma unroll
                        for (int ks = 0; ks < 4; ++ks) hacc = __builtin_amdgcn_mfma_f32_32x32x16_bf16(af[ks], xw[ks], hacc, 0, 0, 0);
                    }
                }
                __syncthreads();
#pragma unroll
                for (int qd = 0; qd < 4; ++qd) { u32x2 w; w.x = cvt_pk_bf16(hacc[4 * qd], hacc[4 * qd + 1]); w.y = cvt_pk_bf16(hacc[4 * qd + 2], hacc[4 * qd + 3]);
                    *(LAS u32x2*)(HS + offb(32 * pb + r32, 4 * lb + qd) + 8 * hi) = w; }
                if (outp) {
#pragma unroll
                    for (int qd = 0; qd < 4; ++qd) { const f32x4 ea = *(LAS const f32x4*)(eac + 32 * lb + 8 * qd + 4 * hi);
#pragma unroll
                        for (int e = 0; e < 4; ++e) YST[(32 * lb + 8 * qd + 4 * hi + e) * 64 + 32 * pb + r32] = yacc[4 * qd + e] + ea[e] * sacc[4 * qd + e]; }
                }
                if (c + 1 < 66) SSD_TILES(c3n);
                if (wid == 0 && c + 2 < 66) {
                    if (c + 3 < 66) { dts[((c + 1) & 1) * 128 + 2 * lane] = dT0; dts[((c + 1) & 1) * 128 + 2 * lane + 1] = dT1; }
                    const float s0 = dts[(c & 1) * 128 + 2 * lane], s1 = dts[(c & 1) * 128 + 2 * lane + 1];
                    SSD_SCAN(c3nn, s0, s1);
                    if (c + 4 < 66) SSD_LOADDT(c + 4, dT0, dT1);
                }
                c3 = c3n;
                __syncthreads();
                if (c + 2 < 66) SSD_PREFETCH(c + 2);
                if (outp) {
#pragma unroll
                    for (int i = 0; i < 2; ++i) { const int v = tid + 512 * i, l = v >> 3, pv8 = v & 7;
                        const f32x4 y0 = *(LAS const f32x4*)(YST + l * 64 + 8 * pv8), y1 = *(LAS const f32x4*)(YST + l * 64 + 8 * pv8 + 4);
                        float y[8] = {y0.x, y0.y, y0.z, y0.w, y1.x, y1.y, y1.z, y1.w};
                        const int jrow = j0 + sgn * l;
                        bf16_t* yp = YS + ((size_t)b * SEQ + (jrow - CTXL)) * DIN + h * 64 + 8 * pv8;
                        if (dir) { float yf[8], xs[8]; unpack8(*(const u32x4*)yp, yf); unpack8(*(const u32x4*)(XBC + ((size_t)b * RPB + jrow) * CONVD + h * 64 + 8 * pv8), xs);
#pragma unroll
                            for (int e = 0; e < 8; ++e) y[e] += yf[e] + Dk * xs[e]; }
                        *(u32x4*)yp = pack8(y); }
                }
            }
            __syncthreads();
#undef SSD_J0
#undef SSD_PREFETCH
#undef SSD_SCAN
#undef SSD_LOADDT
#undef SSD_TILES
        }
    }
}

constexpr int PH_KIND0[24] = {0, 1, 2, 3, 4, 2, 1, 2, 2, 1, 2, 9, 2, 2, 1, 2, 2, 1, 99, 99, 99, 99, 99, 99};
constexpr int PH_ARG0[24]  = {0, 0, 0, 0, 0, 1, 1, 2, 3, 2, 4, 0, 5, 6, 3, 7, 8, 4, 0, 0, 0, 0, 0, 0};
#ifndef DUP_PH
#define DUP_PH -1
#endif
constexpr int ph_src(int i) { return (DUP_PH >= 0 && i > DUP_PH) ? i - 1 : i; }
#define NPH_RUN (18 + (DUP_PH >= 0 ? 1 : 0))
#ifndef PHMASK
#define PHMASK 0x3ff
#endif
#define EN(k) (((PHMASK) >> (k)) & 1)

template <int PH>
__device__ __forceinline__ void run_phase(cg::grid_group& grid, unsigned char* smem, const int wave_s) {
    if constexpr (PH < NPH_RUN) {
    constexpr int kind = PH_KIND0[ph_src(PH)], arg = PH_ARG0[ph_src(PH)];
    LAS unsigned char* lds = (LAS unsigned char*)smem;
    KP P = (KP)__builtin_amdgcn_kernarg_segment_ptr();
    asm volatile("" : "+s"(P));
    int G = gridDim.x; asm volatile("" : "+s"(G));
    int tidx_; asm volatile("v_mbcnt_lo_u32_b32 %0, -1, 0\n\tv_mbcnt_hi_u32_b32 %0, -1, %0" : "=v"(tidx_)); tidx_ += wave_s * 64;
    int bidx_ = __builtin_amdgcn_workgroup_id_x(); asm volatile("" : "+s"(bidx_));
    unsigned char* ws = P->ws;
    const float* NW = P->in[I_NORMW];
    bf16_t* YX = (bf16_t*)(ws + WS_YX);
    if constexpr (kind == 2 && EN(2)) {
        pg8::Gemm g; pg8::EpiMulti E; E.mode = 0; E.dt = nullptr; E.dtb = nullptr; E.rowss = (float*)(ws + WS_ROWSS); g.amap = 0; g.cmode = 0; E.halo = (bf16_t*)(ws + WS_HALO); E.halomode = 0; E.cw = nullptr; E.cbias = nullptr; E.rspace = 1; E.Mrows = 0;
        if constexpr (arg == 0) { g.A = YX; g.lda = 1024; g.Bt = (const bf16_t*)(ws + W_AIN); g.M = MR; g.N = INA; g.K = 1024; E.O = (bf16_t*)(ws + BIG_U); E.ldc = INA; }
        else if constexpr (arg == 1) { g.A = (const bf16_t*)(ws + BIG_MIX); g.lda = 1024; g.Bt = (const bf16_t*)(ws + W_AOUT); g.M = MR; g.N = 1024; g.K = 1024; E.O = YX; E.ldc = 1024; }
        else if constexpr (arg == 2) { g.A = YX; g.lda = 1024; g.Bt = (const bf16_t*)(ws + W_UP0); g.M = MR; g.N = DFF2; g.K = 1024; g.cmode = 1; E.mode = 4; E.O = (bf16_t*)(ws + BIG_H); E.ldc = DFF; E.cw = P->in[I_FCW]; E.cbias = P->in[I_FCB]; E.rspace = 1; E.Mrows = MR; }
        else if constexpr (arg == 3) { g.A = (const bf16_t*)(ws + BIG_H); g.lda = DFF; g.Bt = (const bf16_t*)(ws + W_DN0); g.M = MR; g.N = 1024; g.K = DFF; E.O = YX; E.ldc = 1024; }
        else if constexpr (arg == 4) { g.A = YX; g.lda = 1024; g.Bt = (const bf16_t*)(ws + W_SIN) + (size_t)DIN * 1024; g.M = MR; g.N = NXD; g.K = 1024; g.cmode = 2; E.mode = 5; E.O = (bf16_t*)(ws + BIG_XBC); E.ldc = CONVD;
                E.dt = (float*)(ws + BIG_DT); E.dtb = P->in[I_SDTB]; E.cw = P->in[I_SCW]; E.cbias = P->in[I_SCB]; E.rspace = 1; E.Mrows = MR; }
        else if constexpr (arg == 5) { g.A = YX; g.lda = 1024; g.amap = 1; g.Bt = (const bf16_t*)(ws + W_SIN); g.M = MT; g.N = DIN; g.K = 1024; E.mode = 2; E.O = (bf16_t*)(ws + BIG_YS); E.ldc = DIN; }
        else if constexpr (arg == 6) { g.A = (const bf16_t*)(ws + BIG_YS); g.lda = DIN; g.Bt = (const bf16_t*)(ws + W_SOUT); g.M = MT; g.N = 1024; g.K = DIN; E.mode = 3; E.O = (bf16_t*)(ws + BIG_YOUT); E.ldc = 1024; }
        else if constexpr (arg == 7) { g.A = YX; g.lda = 1024; g.Bt = (const bf16_t*)(ws + W_UP1); g.M = MT; g.N = DFF2; g.K = 1024; g.cmode = 1; E.mode = 4; E.O = (bf16_t*)(ws + BIG_H); E.ldc = DFF; E.cw = P->in[I_FCW] + (size_t)DFF2 * 3; E.cbias = P->in[I_FCB] + DFF2; E.rspace = 0; E.Mrows = MT; }
        else { g.A = (const bf16_t*)(ws + BIG_H); g.lda = DFF; g.Bt = (const bf16_t*)(ws + W_DN1); g.M = MT; g.N = 1024; g.K = DFF; E.O = YX; E.ldc = 1024; }
        pg8::StaticOrder S; S.init(g.cmode == 1 ? (g.M + 247) / 248 : g.cmode == 2 ? (g.M + 249) / 250 : g.M / pg8::BM, g.N, G, bidx_);
        pg8::gemm_phase<pg8::EpiMulti, pg8::StaticOrder>(lds, g, S, E, tidx_);
    } else if constexpr (kind == 1 && EN(1)) {
        RwDesc d; d.srcL = nullptr; d.srcC = nullptr; d.xsrc = nullptr; d.xdst = nullptr; d.odst = nullptr; d.Y = nullptr; d.nwA = nullptr; d.gate_k = 0; d.nwB = nullptr; d.shift_k = 0; d.scale_k = 0; d.XN = YX;
        bf16_t* XRES = (bf16_t*)(ws + WS_XRES);
        if constexpr (arg == 0) { d.rows = MR; d.rspace = 1; d.layer = 0; d.layerB = 0; d.srcL = P->in[I_X]; d.srcC = P->in[I_CTX]; d.nwB = NW + 0 * 1024; d.shift_k = 0; d.scale_k = 1; }
        else if constexpr (arg == 1) { d.rows = MR; d.rspace = 1; d.layer = 0; d.layerB = 0; d.srcL = P->in[I_X]; d.srcC = P->in[I_CTX]; d.xdst = XRES; d.Y = YX; d.nwA = NW + 1 * 1024; d.gate_k = 2; d.nwB = NW + 2 * 1024; d.shift_k = 3; d.scale_k = 4; }
        else if constexpr (arg == 2) { d.rows = MR; d.rspace = 1; d.layer = 0; d.layerB = 1; d.xsrc = XRES; d.xdst = XRES; d.Y = YX; d.nwA = NW + 3 * 1024; d.gate_k = 5; d.nwB = NW + 4 * 1024; d.shift_k = 0; d.scale_k = 1; }
        else if constexpr (arg == 3) { d.rows = MT; d.rspace = 0; d.layer = 1; d.layerB = 1; d.xsrc = XRES; d.xdst = XRES; d.Y = (const bf16_t*)(ws + BIG_YOUT); d.nwA = NW + 5 * 1024; d.gate_k = 2; d.nwB = NW + 6 * 1024; d.shift_k = 3; d.scale_k = 4; }
        else { d.rows = MT; d.rspace = 0; d.layer = 1; d.layerB = 1; d.xsrc = XRES; d.odst = P->out; d.Y = YX; d.nwA = NW + 7 * 1024; d.gate_k = 5; d.XN = nullptr; }
        phase_rw(P, d, G, tidx_, bidx_);
    } else if constexpr (kind == 0 && EN(0)) phase_p0(P, lds, G, tidx_, bidx_);
    else if constexpr (kind == 3 && EN(3)) phase_qkp(P, lds, G, tidx_, bidx_);
    else if constexpr (kind == 4 && EN(4)) phase_attn(P, (char*)smem, G, tidx_, bidx_);
    else if constexpr (kind == 5 && EN(5)) phase_halo_f(P, arg ? MT : MR, G, tidx_, bidx_);
    else if constexpr (kind == 6 && EN(6)) phase_cg(P, arg ? MT : MR, arg ? 0 : 1, arg, G, tidx_, bidx_);
    else if constexpr (kind == 7 && EN(7)) phase_halo_s(P, G, tidx_, bidx_);
    else if constexpr (kind == 8 && EN(8)) phase_conv_s(P, G, tidx_, bidx_);
    else if constexpr (kind == 9 && EN(9)) phase_ssd(P, lds, G, tidx_, bidx_);
    asm volatile("s_waitcnt vmcnt(0)" ::: "memory");
    __syncthreads();
    if (tidx_ == 0) {
        unsigned* bar = (unsigned*)(ws + WS_BAR);
        const unsigned xcc = (unsigned)__builtin_amdgcn_s_getreg((3 << 11) | 20) & 0xFu;
        const unsigned nloc = __hip_atomic_load(bar + 16 * (1 + xcc), __ATOMIC_RELAXED, __HIP_MEMORY_SCOPE_AGENT);
        unsigned nx = 0;
#pragma unroll
        for (int j = 0; j < 16; ++j) nx += __hip_atomic_load(bar + 16 * (1 + j), __ATOMIC_RELAXED, __HIP_MEMORY_SCOPE_AGENT) ? 1u : 0u;
        const unsigned old = __hip_atomic_fetch_add(bar + 16 * (17 + xcc), 1u, __ATOMIC_RELAXED, __HIP_MEMORY_SCOPE_AGENT);
        if (old + 1u == (unsigned)(PH + 1) * nloc) {
            __builtin_amdgcn_fence(__ATOMIC_RELEASE, "agent"); asm volatile("s_waitcnt vmcnt(0)" ::: "memory");
            __hip_atomic_fetch_add(bar, 1u, __ATOMIC_RELAXED, __HIP_MEMORY_SCOPE_AGENT);
            const unsigned want = (unsigned)(PH + 1) * nx;
            while (__hip_atomic_load(bar, __ATOMIC_RELAXED, __HIP_MEMORY_SCOPE_AGENT) < want) __builtin_amdgcn_s_sleep(1);
            __hip_atomic_fetch_add(bar + 16 * (33 + xcc), 1u, __ATOMIC_RELAXED, __HIP_MEMORY_SCOPE_AGENT);
        } else {
            while (__hip_atomic_load(bar + 16 * (33 + xcc), __ATOMIC_RELAXED, __HIP_MEMORY_SCOPE_AGENT) < (unsigned)(PH + 1)) __builtin_amdgcn_s_sleep(1);
        }
        __builtin_amdgcn_fence(__ATOMIC_ACQUIRE, "agent"); asm volatile("s_waitcnt vmcnt(0)" ::: "memory");
    }
    __syncthreads();
    }
}

__global__ void __launch_bounds__(512) mega(Params Pk) {
    extern __shared__ __attribute__((aligned(16))) unsigned char smem[];
    cg::grid_group grid = cg::this_grid();
    const int wave_s = __builtin_amdgcn_readfirstlane((int)__builtin_amdgcn_workitem_id_x() >> 6);
    if (threadIdx.x == 0) {
        const unsigned xcc = (unsigned)__builtin_amdgcn_s_getreg((3 << 11) | 20) & 0xFu;
        __hip_atomic_fetch_add((unsigned*)(Pk.ws + WS_BAR) + 16 * (1 + xcc), 1u, __ATOMIC_RELAXED, __HIP_MEMORY_SCOPE_AGENT);
    }
    grid.sync();
    run_phase<0>(grid, smem, wave_s);  run_phase<1>(grid, smem, wave_s);  run_phase<2>(grid, smem, wave_s);  run_phase<3>(grid, smem, wave_s);
    run_phase<4>(grid, smem, wave_s);  run_phase<5>(grid, smem, wave_s);  run_phase<6>(grid, smem, wave_s);  run_phase<7>(grid, smem, wave_s);
    run_phase<8>(grid, smem, wave_s);  run_phase<9>(grid, smem, wave_s);  run_phase<10>(grid, smem, wave_s); run_phase<11>(grid, smem, wave_s);
    run_phase<12>(grid, smem, wave_s); run_phase<13>(grid, smem, wave_s); run_phase<14>(grid, smem, wave_s); run_phase<15>(grid, smem, wave_s);
    run_phase<16>(grid, smem, wave_s); run_phase<17>(grid, smem, wave_s); run_phase<18>(grid, smem, wave_s); run_phase<19>(grid, smem, wave_s);
    run_phase<20>(grid, smem, wave_s); run_phase<21>(grid, smem, wave_s); run_phase<22>(grid, smem, wave_s); run_phase<23>(grid, smem, wave_s);
}

extern "C" void kernel_launch(void* const* d_in, const int* in_sizes, int n_in, void* d_out, int out_size, void* d_ws, size_t ws_size, hipStream_t stream) {
    static int grid_blocks = 0;
    if (grid_blocks == 0) {
        if (n_in != 25 || ws_size < WS_END) { fprintf(stderr, "kernel_launch: unexpected n_in %d or ws_size %zu (need %zu)\n", n_in, ws_size, (size_t)WS_END); grid_blocks = -1; return; }
        int dev = 0, cus = 0, per_cu = 0;
        hipGetDevice(&dev);
        hipDeviceGetAttribute(&cus, hipDeviceAttributeMultiprocessorCount, dev);
        if (hipFuncSetAttribute((const void*)mega, hipFuncAttributeMaxDynamicSharedMemorySize, LDS_BYTES) != hipSuccess) { fprintf(stderr, "kernel_launch: hipFuncSetAttribute failed\n"); grid_blocks = -1; return; }
        hipOccupancyMaxActiveBlocksPerMultiprocessor(&per_cu, (const void*)mega, 512, LDS_BYTES);
        if (per_cu < 1) { fprintf(stderr, "kernel_launch: occupancy query says %d blocks per CU\n", per_cu); per_cu = 1; }
        (void)hipGetLastError();
        grid_blocks = cus;
    }
    if (grid_blocks < 0) return;
    (void)hipMemsetAsync((char*)d_ws + WS_BAR, 0, 4096, stream);
    Params p{};
    for (int i = 0; i < 25; ++i) p.in[i] = (const float*)d_in[i];
    p.out = (float*)d_out; p.ws = (unsigned char*)d_ws;
    void* args[] = {&p};
    hipError_t e = hipLaunchCooperativeKernel((const void*)mega, dim3(grid_blocks), dim3(512), args, LDS_BYTES, stream);
    if (e != hipSuccess) fprintf(stderr, "cooperative launch failed: %s (grid %d)\n", hipGetErrorString(e), grid_blocks);
}
```
